# Optimizing an MI355X kernel written in HIP

```python
import jax, jax.numpy as jnp
from jax import lax
import numpy as np

D_MODEL = 1024
BATCH = 16
SEQ = 256
DEPTH = 4
DEC_BATCH = 4
DEC_SEQ = 2048
PAST_LEN = 256

GRID_W = 64
EPS = 1e-6
GLA_DK = 64
GLA_DV = 64
GLA_WIDTH = 3 * D_MODEL // 8
GLA_HEADS = GLA_WIDTH // GLA_DV
GLA_LOWRANK = 16
GLA_TAU = 16.0
GLA_CHUNK = 64
CONV_WIDTH = D_MODEL // 4
CONV_K = 3
NA_HD = 64
NA_WIDTH = 3 * D_MODEL // 8
NA_HEADS = NA_WIDTH // NA_HD
NA_MAX_ROWS = 8
NA_COLS = 16
CTX_BLOCK = 128
MIX_WIDTH = GLA_WIDTH + CONV_WIDTH + NA_WIDTH
PEER_HEADS = 8
PEER_NKEYS = 128
PEER_EXPERTS = PEER_NKEYS * PEER_NKEYS
PEER_DKEY = 128
PEER_TOPK = 16
PEER_CHUNK = 128

SPLIT_SIZES = (GLA_HEADS * GLA_DK, GLA_HEADS * GLA_DK, GLA_WIDTH, GLA_WIDTH,
               GLA_LOWRANK, GLA_LOWRANK,
               CONV_WIDTH, CONV_WIDTH, CONV_WIDTH,
               NA_WIDTH, NA_WIDTH, NA_WIDTH)
IN_WIDTH = 4 * GLA_WIDTH + 2 * GLA_LOWRANK + 3 * CONV_WIDTH + 3 * NA_WIDTH

kernel_name = "hymba_gla_conv_natten_peer_diffusion_step"


def rmsnorm(x, w):
    xf = x.astype(jnp.float32)
    y = xf * lax.rsqrt(jnp.mean(xf * xf, axis=-1, keepdims=True) + EPS) * w.astype(jnp.float32)
    return y.astype(x.dtype)


def modulate(cvec, w_ada, b_ada):
    m = (jax.nn.silu(cvec) @ w_ada + b_ada)[:, None, :]
    return jnp.split(m, 6, axis=-1)


def heads(a, n_heads):
    b, t, w = a.shape
    return a.reshape(b, t, n_heads, w // n_heads).transpose(0, 2, 1, 3)


def merge_heads(a):
    b, h, t, d = a.shape
    return a.transpose(0, 2, 1, 3).reshape(b, t, h * d)


def split_proj(h, w_in):
    z = h @ w_in
    cuts = [int(i) for i in np.cumsum(SPLIT_SIZES)[:-1]]
    return jnp.split(z, cuts, axis=-1)


def gla_chunked(q, k, v, log_a, s0):
    f32 = jnp.float32
    q, k, v, log_a = q.astype(f32), k.astype(f32), v.astype(f32), log_a.astype(f32)
    b_, h_, t_, _ = q.shape
    nc = t_ // GLA_CHUNK

    def to_chunks(a):
        return a.reshape(b_, h_, nc, GLA_CHUNK, a.shape[-1]).transpose(2, 0, 1, 3, 4)

    causal = jnp.tril(jnp.ones((GLA_CHUNK, GLA_CHUNK), dtype=bool))[:, :, None]

    def step(s, inp):
        qc, kc, vc, ac = inp
        cum = jnp.cumsum(ac, axis=-2)
        inter = jnp.einsum('bhtk,bhkv->bhtv', qc * jnp.exp(cum), s)
        diff = cum[:, :, :, None, :] - cum[:, :, None, :, :]
        decay = jnp.exp(jnp.where(causal, diff, -jnp.inf))
        att = jnp.einsum('bhtk,bhsk,bhtsk->bhts', qc, kc, decay)
        intra = jnp.einsum('bhts,bhsv->bhtv', att, vc)
        last = cum[:, :, -1:, :]
        s_new = jnp.exp(last[:, :, 0, :])[..., None] * s + jnp.einsum(
            'bhsk,bhsv->bhkv', kc * jnp.exp(last - cum), vc)
        return s_new, inter + intra

    s_fin, o = lax.scan(step, s0.astype(f32), (to_chunks(q), to_chunks(k), to_chunks(v), to_chunks(log_a)))
    o = o.transpose(1, 2, 0, 3, 4).reshape(b_, h_, t_, v.shape[-1])
    return o, s_fin


def gla_bidir(q, k, v, la_f, la_b, s0_f, s0_b):
    o_f, s_f = gla_chunked(q, k, v, la_f, s0_f)
    flip = lambda a: a[:, :, ::-1]
    o_b, s_b = gla_chunked(flip(q), flip(k), flip(v), flip(la_b), s0_b)
    return o_f + flip(o_b), s_f, s_b


def log_decay(lr, w_a, b_a):
    return jax.nn.log_sigmoid((lr @ w_a + b_a).astype(jnp.float32)) / GLA_TAU


def gla_output(o, g, w):
    o = o.transpose(0, 2, 1, 3)
    o = o * lax.rsqrt(jnp.mean(o * o, axis=-1, keepdims=True) + EPS) * w.astype(jnp.float32).reshape(GLA_HEADS, GLA_DV)
    b_, t_ = o.shape[0], o.shape[1]
    return o.reshape(b_, t_, GLA_WIDTH).astype(g.dtype) * jax.nn.silu(g)


def short_conv(u, w, b):
    up = jnp.pad(u, ((0, 0), (1, 1), (0, 0)))
    return w[0] * up[:, :-2] + w[1] * up[:, 1:-1] + w[2] * up[:, 2:] + b


def dense_attention(q, k, v):
    b_, h_, s_, d_ = q.shape
    nb = s_ // CTX_BLOCK
    qb = q.reshape(b_, h_, nb, CTX_BLOCK, d_).transpose(2, 0, 1, 3, 4)
    scale = d_ ** -0.5

    def blk(qi):
        s = jnp.einsum('bhqd,bhkd->bhqk', qi, k).astype(jnp.float32) * scale
        p = jax.nn.softmax(s, axis=-1).astype(v.dtype)
        return jnp.einsum('bhqk,bhkd->bhqd', p, v)

    o = lax.map(blk, qb)
    return o.transpose(1, 2, 0, 3, 4).reshape(b_, h_, s_, d_)


def neighbourhood_attention(q, k, v, k_ctx, v_ctx, rpb):
    b_, h_, t_, d_ = q.shape
    rows = t_ // GRID_W
    wr = min(NA_MAX_ROWS, rows)
    nwin = wr * GRID_W
    r = np.arange(rows)
    rs = np.clip(r - wr // 2, 0, rows - wr)
    key_rows = rs[:, None] + np.arange(wr)[None, :]
    cols = np.arange(GRID_W)
    cs = np.clip(cols - NA_COLS // 2, 0, GRID_W - NA_COLS)
    kcol = np.arange(nwin) % GRID_W
    col_mask = (kcol[None, :] >= cs[:, None]) & (kcol[None, :] < cs[:, None] + NA_COLS)
    dr = np.repeat(key_rows - r[:, None], GRID_W, axis=1)
    dc = np.clip(kcol[None, :] - cols[:, None], -(NA_COLS - 1), NA_COLS - 1)
    bias = rpb[:, dr[:, None, :] + NA_MAX_ROWS - 1, dc[None, :, :] + NA_COLS - 1].astype(jnp.float32)

    qg = q.reshape(b_, h_, rows, GRID_W, d_)
    kw = k.reshape(b_, h_, rows, GRID_W, d_)[:, :, key_rows].reshape(b_, h_, rows, nwin, d_)
    vw = v.reshape(b_, h_, rows, GRID_W, d_)[:, :, key_rows].reshape(b_, h_, rows, nwin, d_)
    scale = d_ ** -0.5
    s_win = jnp.einsum('bhrqd,bhrkd->bhrqk', qg, kw).astype(jnp.float32) * scale + bias
    s_win = jnp.where(col_mask[None, None, None], s_win, -1e30)
    s_ctx = jnp.einsum('bhrqd,bhcd->bhrqc', qg, k_ctx).astype(jnp.float32) * scale
    p = jax.nn.softmax(jnp.concatenate([s_win, s_ctx], axis=-1), axis=-1).astype(v.dtype)
    o = (jnp.einsum('bhrqk,bhrkd->bhrqd', p[..., :nwin], vw)
         + jnp.einsum('bhrqc,bhcd->bhrqd', p[..., nwin:], v_ctx))
    return o.reshape(b_, h_, t_, d_)


def mix_layer(h, lp, s0_f, s0_b, kv_ctx):
    qa, ka, va, ga, lrf, lrb, ch, cb, cc, qn, kn, vn = split_proj(h, lp['w_in'])
    q = heads(qa, GLA_HEADS) * GLA_DK ** -0.5
    k = heads(ka, GLA_HEADS)
    v = heads(va, GLA_HEADS)
    la_f = heads(log_decay(lrf, lp['w_af'], lp['b_af']), GLA_HEADS)
    la_b = heads(log_decay(lrb, lp['w_ab'], lp['b_ab']), GLA_HEADS)
    o_gla, s_f, s_b = gla_bidir(q, k, v, la_f, la_b, s0_f, s0_b)
    y_gla = gla_output(o_gla, ga, lp['gla_norm_w'])
    y_conv = cb * short_conv(cc * ch, lp['conv_w'], lp['conv_b'])
    qh, kh, vh = heads(qn, NA_HEADS), heads(kn, NA_HEADS), heads(vn, NA_HEADS)
    if kv_ctx is None:
        o_na = dense_attention(qh, kh, vh)
    else:
        o_na = neighbourhood_attention(qh, kh, vh, kv_ctx[0], kv_ctx[1], lp['na_rpb'])
    y = jnp.concatenate([y_gla, y_conv, merge_heads(o_na)], axis=-1) @ lp['w_out']
    return y, (kh, vh, s_f, s_b)


def peer_ffn(h, wq, k1, k2, u, v):
    b_, t_, d_ = h.shape
    n = b_ * t_
    xt = h.reshape(n, d_)
    q = (xt @ wq).reshape(n, PEER_HEADS, PEER_DKEY).astype(jnp.float32)
    half = PEER_DKEY // 2
    s1 = jnp.einsum('thd,hnd->thn', q[..., :half], k1.astype(jnp.float32))
    s2 = jnp.einsum('thd,hnd->thn', q[..., half:], k2.astype(jnp.float32))
    v1, i1 = lax.top_k(s1, PEER_TOPK)
    v2, i2 = lax.top_k(s2, PEER_TOPK)
    cand = (v1[..., :, None] + v2[..., None, :]).reshape(n, PEER_HEADS, PEER_TOPK * PEER_TOPK)
    cidx = (i1[..., :, None] * PEER_NKEYS + i2[..., None, :]).reshape(n, PEER_HEADS, PEER_TOPK * PEER_TOPK)
    top, pos = lax.top_k(cand, PEER_TOPK)
    idx = jnp.take_along_axis(cidx, pos, axis=-1)
    g = jax.nn.softmax(top, axis=-1)
    nc = n // PEER_CHUNK

    def expert_block(args):
        xc, ic, gc = args
        act = jax.nn.gelu(jnp.einsum('td,thkd->thk', xc, u[ic]))
        w = (gc * act.astype(jnp.float32)).astype(xc.dtype)
        return jnp.einsum('thk,thkd->td', w, v[ic])

    out = lax.map(expert_block, (xt.reshape(nc, PEER_CHUNK, d_),
                                 idx.reshape(nc, PEER_CHUNK, PEER_HEADS, PEER_TOPK),
                                 g.reshape(nc, PEER_CHUNK, PEER_HEADS, PEER_TOPK)))
    return out.reshape(b_, t_, d_)


def trunk_layer(x, cvec, lp, s0_f, s0_b, kv_ctx):
    sh1, sc1, g1, sh2, sc2, g2 = modulate(cvec, lp['w_ada'], lp['b_ada'])
    h = rmsnorm(x, lp['norm1_w']) * (1 + sc1) + sh1
    y, st = mix_layer(h, lp, s0_f, s0_b, kv_ctx)
    x = x + g1 * y
    h = rmsnorm(x, lp['norm2_w']) * (1 + sc2) + sh2
    x = x + g2 * peer_ffn(h, lp['peer_wq'], lp['peer_k1'], lp['peer_k2'], lp['peer_u'], lp['peer_v'])
    return x, st


def setup_inputs(seed: int = 0) -> dict:
    key = jax.random.key(seed)
    ks = jax.random.split(key, 32)
    nrm = lambda i, shape, s: jax.random.normal(ks[i], shape, jnp.float32) * s
    D = D_MODEL
    return {
        'x_prompt': nrm(0, (BATCH, SEQ, D), 1.0),
        'x_sample': nrm(1, (DEC_BATCH, DEC_SEQ, D), 1.0),
        'cache_na_k': nrm(2, (DEC_BATCH, DEPTH, NA_HEADS, PAST_LEN, NA_HD), 1.0),
        'cache_na_v': nrm(3, (DEC_BATCH, DEPTH, NA_HEADS, PAST_LEN, NA_HD), 1.0),
        'state_gla_fwd': nrm(4, (DEC_BATCH, DEPTH, GLA_HEADS, GLA_DK, GLA_DV), 1.0),
        'state_gla_bwd': nrm(5, (DEC_BATCH, DEPTH, GLA_HEADS, GLA_DK, GLA_DV), 1.0),
        'c': nrm(6, (DEC_BATCH, D), 1.0),
        'c_ctx': nrm(7, (D,), 1.0),
        'w_ada': nrm(8, (DEPTH, D, 6 * D), 0.5 * D ** -0.5),
        'b_ada': nrm(9, (DEPTH, 6 * D), 0.01),
        'norm1_w': 1.0 + nrm(10, (DEPTH, D), 0.01),
        'norm2_w': 1.0 + nrm(11, (DEPTH, D), 0.01),
        'w_in': nrm(12, (DEPTH, D, IN_WIDTH), D ** -0.5),
        'w_af': nrm(13, (DEPTH, GLA_LOWRANK, GLA_HEADS * GLA_DK), GLA_LOWRANK ** -0.5),
        'b_af': nrm(14, (DEPTH, GLA_HEADS * GLA_DK), 0.1),
        'w_ab': nrm(15, (DEPTH, GLA_LOWRANK, GLA_HEADS * GLA_DK), GLA_LOWRANK ** -0.5),
        'b_ab': nrm(16, (DEPTH, GLA_HEADS * GLA_DK), 0.1),
        'gla_norm_w': 1.0 + nrm(17, (DEPTH, GLA_WIDTH), 0.01),
        'conv_w': nrm(18, (DEPTH, CONV_K, CONV_WIDTH), CONV_K ** -0.5),
        'conv_b': nrm(19, (DEPTH, CONV_WIDTH), 0.01),
        'na_rpb': nrm(20, (DEPTH, NA_HEADS, 2 * NA_MAX_ROWS - 1, 2 * NA_COLS - 1), 0.1),
        'w_out': nrm(21, (DEPTH, MIX_WIDTH, D), MIX_WIDTH ** -0.5),
        'peer_wq': nrm(22, (DEPTH, D, PEER_HEADS * PEER_DKEY), D ** -0.5),
        'peer_k1': nrm(23, (DEPTH, PEER_HEADS, PEER_NKEYS, PEER_DKEY // 2), (PEER_DKEY // 2) ** -0.5),
        'peer_k2': nrm(24, (DEPTH, PEER_HEADS, PEER_NKEYS, PEER_DKEY // 2), (PEER_DKEY // 2) ** -0.5),
        'peer_u': nrm(25, (DEPTH, PEER_EXPERTS, D), D ** -0.5),
        'peer_v': nrm(26, (DEPTH, PEER_EXPERTS, D), 0.25),
        'final_norm_w': 1.0 + nrm(27, (D,), 0.01),
    }


def reference(x_prompt, x_sample, cache_na_k, cache_na_v, state_gla_fwd, state_gla_bwd, c, c_ctx,
              w_ada, b_ada, norm1_w, norm2_w, w_in, w_af, b_af, w_ab, b_ab, gla_norm_w,
              conv_w, conv_b, na_rpb, w_out, peer_wq, peer_k1, peer_k2, peer_u, peer_v, final_norm_w):
    x_p = x_prompt
    x_s = x_sample
    zeros_state = jnp.zeros((x_prompt.shape[0], GLA_HEADS, GLA_DK, GLA_DV), jnp.float32)
    new_k, new_v, new_sf, new_sb = [], [], [], []
    for l in range(DEPTH):
        lp = {'w_ada': w_ada[l], 'b_ada': b_ada[l], 'norm1_w': norm1_w[l], 'norm2_w': norm2_w[l],
              'w_in': w_in[l], 'w_af': w_af[l], 'b_af': b_af[l], 'w_ab': w_ab[l], 'b_ab': b_ab[l],
              'gla_norm_w': gla_norm_w[l], 'conv_w': conv_w[l], 'conv_b': conv_b[l],
              'na_rpb': na_rpb[l], 'w_out': w_out[l], 'peer_wq': peer_wq[l], 'peer_k1': peer_k1[l],
              'peer_k2': peer_k2[l], 'peer_u': peer_u[l], 'peer_v': peer_v[l]}
        x_p, (kc, vc, sf, sb) = trunk_layer(x_p, c_ctx[None, :], lp, zeros_state, zeros_state, None)
        new_k.append(kc)
        new_v.append(vc)
        new_sf.append(sf)
        new_sb.append(sb)
        x_s, _ = trunk_layer(x_s, c, lp, state_gla_fwd[:, l], state_gla_bwd[:, l],
                             (cache_na_k[:, l], cache_na_v[:, l]))
    y_prompt = rmsnorm(x_p, final_norm_w)
    y_sample = rmsnorm(x_s, final_norm_w)
    new_na_k = jnp.stack(new_k, axis=1)
    new_na_v = jnp.stack(new_v, axis=1)
    new_gla_fwd = jnp.stack(new_sf, axis=1)
    new_gla_bwd = jnp.stack(new_sb, axis=1)
    return (y_prompt, y_sample, new_na_k, new_na_v, new_gla_fwd, new_gla_bwd)
```

```cpp
#include <hip/hip_runtime.h>
#include <cstdio>
#include <cstdint>
#include <cstddef>

#ifndef MULTI_LAUNCH
#define MULTI_LAUNCH 0
#endif

typedef unsigned short bf16;
typedef __attribute__((ext_vector_type(8))) short bf16x8;
typedef __attribute__((ext_vector_type(4))) float f32x4;
typedef __attribute__((ext_vector_type(16))) float f32x16;

#define DEVI __device__ __forceinline__
#define LAS __attribute__((address_space(3)))

constexpr int D = 1024;
constexpr int NTOK = 12288;
constexpr int NPROMPT = 4096;
constexpr int NLAYER = 4;
constexpr int ZW = 2816;
constexpr int ZC_QA = 0, ZC_KA = 384, ZC_GA = 768, ZC_QN = 1152, ZC_KN = 1536, ZC_CH = 1920, ZC_CB = 2176, ZC_CC = 2432,
              ZC_LRF = 2688, ZC_LRB = 2704;
constexpr int WIN_ROWS = 3584;
constexpr int NCHUNK = NTOK / 64;
constexpr int NGITEM = NCHUNK * 6;
constexpr float EPS = 1e-6f;

constexpr size_t O_Y = 0;
constexpr size_t O_NK = 12582912;
constexpr size_t O_NV = 18874368;
constexpr size_t O_GF = 25165824;
constexpr size_t O_GB = 26738688;

constexpr size_t al256(size_t x) { return (x + 255) & ~(size_t)255; }
constexpr size_t OFF_CTL = 0;
constexpr size_t OFF_MOD = 32768;
constexpr size_t OFF_WIN = al256(OFF_MOD + (size_t)4 * 5 * 6144 * 4);
constexpr size_t OFF_WOUT = al256(OFF_WIN + (size_t)4 * WIN_ROWS * 1024 * 2);
constexpr size_t OFF_WQ = al256(OFF_WOUT + (size_t)4 * 1024 * 1024 * 2);
constexpr size_t OFF_PU = al256(OFF_WQ + (size_t)4 * 1024 * 1024 * 2);
constexpr size_t OFF_PV = al256(OFF_PU + (size_t)4 * 16384 * 1024);
constexpr size_t OFF_SU = al256(OFF_PV + (size_t)4 * 16384 * 1024);
constexpr size_t OFF_SV = al256(OFF_SU + (size_t)4 * 16384 * 4);
constexpr size_t OFF_CK = al256(OFF_SV + (size_t)4 * 16384 * 4);
constexpr size_t OFF_CVT = al256(OFF_CK + (size_t)4 * 4 * 6 * 256 * 64 * 2);
constexpr size_t OFF_K1 = al256(OFF_CVT + (size_t)4 * 4 * 6 * 256 * 64 * 2);
constexpr size_t OFF_K2 = al256(OFF_K1 + (size_t)4 * 8 * 128 * 64 * 2);
constexpr size_t OFF_XW = al256(OFF_K2 + (size_t)4 * 8 * 128 * 64 * 2);
constexpr size_t OFF_H = al256(OFF_XW + (size_t)NTOK * 1024 * 4);
constexpr size_t OFF_Z = al256(OFF_H + (size_t)NTOK * 1024 * 2);
constexpr size_t OFF_VTA = al256(OFF_Z + (size_t)NTOK * ZW * 2);
constexpr size_t OFF_VTN = al256(OFF_VTA + (size_t)384 * NTOK * 2);
constexpr size_t OFF_QT = al256(OFF_VTN + (size_t)384 * NTOK * 2);
constexpr size_t OFF_OINTRA = al256(OFF_QT + (size_t)2 * NTOK * 384 * 2);
constexpr size_t OFF_UST = al256(OFF_OINTRA + (size_t)NTOK * 384 * 4);
constexpr size_t OFF_DEC = al256(OFF_UST + (size_t)NGITEM * 2 * 4096 * 4);
constexpr size_t OFF_SST = al256(OFF_DEC + (size_t)NGITEM * 2 * 64 * 4);
constexpr size_t OFF_YMIX = al256(OFF_SST + (size_t)NGITEM * 2 * 4096 * 2);
constexpr size_t OFF_QP = al256(OFF_YMIX + (size_t)NTOK * 1024 * 2);
constexpr size_t OFF_PIDX = al256(OFF_QP + (size_t)NTOK * 1024 * 2);
constexpr size_t OFF_PG = al256(OFF_PIDX + (size_t)NTOK * 128 * 4);
constexpr size_t OFF_ACT = al256(OFF_PG + (size_t)NTOK * 128 * 4);
constexpr size_t OFF_QNF = al256(OFF_ACT + (size_t)NTOK * 128 * 4);
constexpr size_t OFF_KNF = al256(OFF_QNF + (size_t)6 * NTOK * 64 * 2);
constexpr size_t OFF_QAF = al256(OFF_KNF + (size_t)6 * NTOK * 64 * 2);
constexpr size_t OFF_KAF = al256(OFF_QAF + (size_t)6 * NTOK * 64 * 2);
constexpr size_t OFF_PART = al256(OFF_KAF + (size_t)6 * NTOK * 64 * 2);
constexpr size_t OFF_PGS = al256(OFF_PART + 256);
constexpr size_t OFF_H8 = al256(OFF_PGS + (size_t)NTOK * 128 * 8);
constexpr size_t OFF_SH8 = al256(OFF_H8 + (size_t)NTOK * 1024);
constexpr size_t WS_END = al256(OFF_SH8 + (size_t)NTOK * 4);

constexpr int LDS_MAIN = 81920;
constexpr int LDS_BYTES = LDS_MAIN;

struct Params {
    const float* in[28];
    float* out;
    unsigned char* ws;
    int ph_lo, ph_hi;
};

DEVI unsigned short f2bf(float f) {
    unsigned u = __float_as_uint(f);
    u += 0x7fffu + ((u >> 16) & 1u);
    return (unsigned short)(u >> 16);
}
DEVI float bf2f(unsigned short h) { return __uint_as_float(((unsigned)h) << 16); }
DEVI unsigned pack2(float a, float b) { return (unsigned)f2bf(a) | ((unsigned)f2bf(b) << 16); }
DEVI unsigned pack_i8x4(float a, float b, float c, float d) {
    const int ia = (int)__builtin_rintf(a), ib = (int)__builtin_rintf(b), ic = (int)__builtin_rintf(c), id = (int)__builtin_rintf(d);
    return ((unsigned)ia & 0xffu) | (((unsigned)ib & 0xffu) << 8) | (((unsigned)ic & 0xffu) << 16) | ((unsigned)id << 24);
}
DEVI float bflo(unsigned u) { return __uint_as_float(u << 16); }
DEVI float bfhi(unsigned u) { return __uint_as_float(u & 0xffff0000u); }
DEVI float silu_f(float x) { return x / (1.f + __expf(-x)); }
DEVI float gelu_tanh_f(float x) {
    float y = 0.7978845608028654f * (x + 0.044715f * x * x * x);
    float e = __expf(2.f * y);
    float t = 1.f - 2.f / (e + 1.f);
    return 0.5f * x * (1.f + t);
}
DEVI float log_sigmoid_f(float x) { return fminf(x, 0.f) - __logf(1.f + __expf(-fabsf(x))); }
DEVI float wave_sum(float v) {
#pragma unroll
    for (int o = 32; o >= 1; o >>= 1) v += __shfl_xor(v, o);
    return v;
}
DEVI bf16x8 ld_frag(const bf16* p) { return *(const bf16x8*)p; }
typedef __attribute__((ext_vector_type(4))) unsigned u32x4;
DEVI bf16x8 mk_frag(uint2 a, uint2 b) {
    u32x4 c = (u32x4){a.x, a.y, b.x, b.y}; return __builtin_bit_cast(bf16x8, c);
}
DEVI bf16x8 mk_frag4(unsigned a, unsigned b, unsigned c_, unsigned d) {
    u32x4 c = (u32x4){a, b, c_, d}; return __builtin_bit_cast(bf16x8, c);
}
DEVI size_t kf_idx(int tok, int d) { return ((((((size_t)(tok >> 3) * 2 + (d >> 5)) * 2 + ((tok >> 2) & 1)) * 4 + ((d >> 3) & 3)) * 4 + (tok & 3)) * 8) + (d & 7); }
DEVI size_t vf_idx(int tok, int dv) { return ((((size_t)(tok >> 3) * 4 + (dv >> 4)) * 16 + (dv & 15)) * 8) + (tok & 7); }
DEVI int opaque_tid() { int t = threadIdx.x; asm volatile("" : "+v"(t)); return t; }
DEVI int tok_modrow(int g) { return g < NPROMPT ? 0 : 1 + ((g - NPROMPT) >> 11); }

#define XB_TMO      128
#define XB_XCNT(j)  (256  + 64 * (j))
#define XB_XSUB(j)  (1280 + 64 * (j))
#define XB_XGEN(j)  (2304 + 64 * (j))
#define XB_TOP      3328
#define XB_TOPGEN   3392
#define XCD_BAR_WORDS 3456
#define XB_SPIN_CAP (1u << 22)
DEVI unsigned xb_ld(unsigned* p) { return __hip_atomic_load(p, __ATOMIC_RELAXED, __HIP_MEMORY_SCOPE_AGENT); }
DEVI unsigned xb_add(unsigned* p, unsigned v) { return __hip_atomic_fetch_add(p, v, __ATOMIC_RELAXED, __HIP_MEMORY_SCOPE_AGENT); }
DEVI unsigned xb_xcc_id() { return (unsigned)__builtin_amdgcn_s_getreg((3 << 11) | 20) & 0xFu; }
#define XB_SPIN(cond, bar) do { unsigned _sp = 0; while (cond) { __builtin_amdgcn_s_sleep(1); \
    if ((++_sp & 255u) == 0u) { if (xb_ld(&(bar)[XB_TMO])) break; if (_sp > XB_SPIN_CAP) { atomicAdd(&(bar)[XB_TMO], 1u); break; } } } } while (0)
struct XcdBarrier { unsigned* bar; unsigned x; unsigned* st; };
DEVI XcdBarrier xcd_barrier_post(unsigned* bar, unsigned* st) {
    XcdBarrier b; b.bar = bar; b.x = xb_xcc_id(); b.st = st;
    if (threadIdx.x == 0) (void)xb_add(&bar[XB_XCNT(b.x)], 1u);
    return b;
}
DEVI void xcd_barrier_complete(unsigned* bar, unsigned x, unsigned& nloc, unsigned& nx) {
    const unsigned G = gridDim.x * gridDim.y * gridDim.z;
    unsigned sum, cnt, mine, sp = 0u;
    for (;;) {
        sum = 0u; cnt = 0u; mine = 0u;
#pragma unroll
        for (unsigned j = 0; j < 16; ++j) { const unsigned c = xb_ld(&bar[XB_XCNT(j)]); sum += c; cnt += (c > 0u) ? 1u : 0u; mine = (j == x) ? c : mine; }
        if (sum == G) break;
        __builtin_amdgcn_s_sleep(1);
        if ((++sp & 255u) == 0u) { if (xb_ld(&bar[XB_TMO])) break; if (sp > XB_SPIN_CAP) { atomicAdd(&bar[XB_TMO], 1u); break; } }
    }
    nloc = mine > 0u ? mine : 1u; nx = cnt > 0u ? cnt : 1u;
}
DEVI void xcd_barrier(const XcdBarrier& b) {
    asm volatile("s_waitcnt vmcnt(0)" ::: "memory");
    __syncthreads();
    if (threadIdx.x == 0) {
        unsigned* bar = b.bar;
        __builtin_amdgcn_s_waitcnt(0);
        unsigned nloc = xb_ld(b.st), nx = xb_ld(b.st + 1);
        if (nloc == 0u) {
            xcd_barrier_complete(bar, b.x, nloc, nx);
            __hip_atomic_store(b.st, nloc, __ATOMIC_RELAXED, __HIP_MEMORY_SCOPE_AGENT);
            __hip_atomic_store(b.st + 1, nx, __ATOMIC_RELAXED, __HIP_MEMORY_SCOPE_AGENT);
        }
        const unsigned old = xb_add(&bar[XB_XSUB(b.x)], 1u);
        const unsigned gen = old / nloc;
        if (old + 1u == (gen + 1u) * nloc) {
            __builtin_amdgcn_fence(__ATOMIC_RELEASE, "agent");
            asm volatile("s_waitcnt vmcnt(0)" ::: "memory");
            const unsigned og = xb_add(&bar[XB_TOP], 1u);
            const unsigned tg = og / nx;
            if (og + 1u == (tg + 1u) * nx) xb_add(&bar[XB_TOPGEN], 1u);
            else XB_SPIN(xb_ld(&bar[XB_TOPGEN]) == tg, bar);
            __builtin_amdgcn_fence(__ATOMIC_ACQUIRE, "agent");
            xb_add(&bar[XB_XGEN(b.x)], 1u);
            asm volatile("s_waitcnt vmcnt(0)" ::: "memory");
        } else {
            XB_SPIN(xb_ld(&bar[XB_XGEN(b.x)]) == gen, bar);
            __builtin_amdgcn_fence(__ATOMIC_ACQUIRE, "agent");
            asm volatile("s_waitcnt vmcnt(0)" ::: "memory");
        }
    }
    __syncthreads();
}

DEVI void phase_mod(const Params& p, unsigned char* smem) {
    float* sv = (float*)smem;
    float* red = sv + 5 * 1024;
    const float* c = p.in[6]; const float* cctx = p.in[7];
    const float* w_ada = p.in[8]; const float* b_ada = p.in[9];
    float* mod = (float*)(p.ws + OFF_MOD);
    const int tid = opaque_tid();
    for (int i = tid; i < 5 * 1024; i += 256) {
        int r = i >> 10, k = i & 1023;
        float x = (r == 0) ? cctx[k] : c[(r - 1) * 1024 + k];
        sv[i] = silu_f(x);
    }
    __syncthreads();
    const int tx = tid & 63, ty = tid >> 6;
    for (int item = blockIdx.x; item < 4 * 96; item += gridDim.x) {
        int l = item / 96, cb = item % 96;
        int col = cb * 64 + tx;
        const float* w = w_ada + (size_t)l * 1024 * 6144 + col;
        float a0 = 0, a1 = 0, a2 = 0, a3 = 0, a4 = 0;
#pragma unroll 8
        for (int k = ty * 256; k < ty * 256 + 256; ++k) {
            float wv = w[(size_t)k * 6144];
            a0 += sv[k] * wv; a1 += sv[1024 + k] * wv; a2 += sv[2048 + k] * wv; a3 += sv[3072 + k] * wv; a4 += sv[4096 + k] * wv;
        }
        red[(ty * 5 + 0) * 64 + tx] = a0; red[(ty * 5 + 1) * 64 + tx] = a1; red[(ty * 5 + 2) * 64 + tx] = a2;
        red[(ty * 5 + 3) * 64 + tx] = a3; red[(ty * 5 + 4) * 64 + tx] = a4;
        __syncthreads();
        if (ty == 0) {
            float bb = b_ada[l * 6144 + col];
#pragma unroll
            for (int r = 0; r < 5; ++r) {
                float s = red[(0 * 5 + r) * 64 + tx] + red[(1 * 5 + r) * 64 + tx] + red[(2 * 5 + r) * 64 + tx] + red[(3 * 5 + r) * 64 + tx];
                mod[((size_t)l * 5 + r) * 6144 + col] = s + bb;
            }
        }
        __syncthreads();
    }
}

template <bool Q8 = false>
DEVI void norm_store_row(const f32x4 (&x)[4], const float* nw, const float* sc, const float* sh, bf16* hrow, int lane, unsigned char* h8row = nullptr, float* sh8 = nullptr) {
    float ss = 0.f;
#pragma unroll
    for (int j = 0; j < 4; ++j) ss += x[j][0] * x[j][0] + x[j][1] * x[j][1] + x[j][2] * x[j][2] + x[j][3] * x[j][3];
    ss = wave_sum(ss);
    float rstd = rsqrtf(ss * (1.f / 1024.f) + EPS);
    f32x4 hq[4]; float am = 0.f;
#pragma unroll
    for (int j = 0; j < 4; ++j) {
        int c0 = 4 * lane + 256 * j;
        f32x4 w = *(const f32x4*)(nw + c0);
        f32x4 s1 = *(const f32x4*)(sc + c0);
        f32x4 s0 = *(const f32x4*)(sh + c0);
        float h0 = x[j][0] * rstd * w[0] * (1.f + s1[0]) + s0[0];
        float h1 = x[j][1] * rstd * w[1] * (1.f + s1[1]) + s0[1];
        float h2 = x[j][2] * rstd * w[2] * (1.f + s1[2]) + s0[2];
        float h3 = x[j][3] * rstd * w[3] * (1.f + s1[3]) + s0[3];
        *(uint2*)(hrow + c0) = make_uint2(pack2(h0, h1), pack2(h2, h3));
        if (Q8) { hq[j] = (f32x4){h0, h1, h2, h3}; am = fmaxf(fmaxf(fmaxf(am, fabsf(h0)), fmaxf(fabsf(h1), fabsf(h2))), fabsf(h3)); }
    }
    if (Q8) {
#pragma unroll
        for (int o = 32; o >= 1; o >>= 1) am = fmaxf(am, __shfl_xor(am, o));
        const float scale = am > 0.f ? am * (1.f / 127.f) : 1.f, inv = 1.f / scale;
#pragma unroll
        for (int j = 0; j < 4; ++j) *(unsigned*)(h8row + 4 * lane + 256 * j) = pack_i8x4(hq[j][0] * inv, hq[j][1] * inv, hq[j][2] * inv, hq[j][3] * inv);
        if (lane == 0) *sh8 = scale;
    }
}

DEVI int win_orig_col(int n) {
    if (n < 768) return n;
    if (n < 1152) return n - 768 + 1152;
    if (n < 1536) return n - 1152 + 2336;
    if (n < 1920) return n - 1536 + 2720;
    if (n < 2688) return n - 1920 + 1568;
    if (n < 2720) return n - 2688 + 1536;
    if (n < 2816) return -1;
    if (n < 3200) return n - 2816 + 768;
    return n - 3200 + 3104;
}
DEVI void transpose_tile(const float* src, int src_ld, bf16* dst, int n0, int k0, int kind, float* tile  ) {
    const int tid = opaque_tid();
    const int nn = tid & 63;
    int oc = kind == 0 ? win_orig_col(n0 + nn) : (n0 + nn);
#pragma unroll 4
    for (int i = 0; i < 16; ++i) {
        int kk = i * 4 + (tid >> 6);
        float v = (oc >= 0) ? src[(size_t)(k0 + kk) * src_ld + oc] : 0.f;
        tile[kk * 65 + nn] = v;
    }
    __syncthreads();
#pragma unroll
    for (int i = 0; i < 2; ++i) {
        int n = (tid >> 3) + 32 * i, kc = tid & 7;
        float v[8];
#pragma unroll
        for (int j = 0; j < 8; ++j) v[j] = tile[(kc * 8 + j) * 65 + n];
        uint4 o = make_uint4(pack2(v[0], v[1]), pack2(v[2], v[3]), pack2(v[4], v[5]), pack2(v[6], v[7]));
        *(uint4*)(dst + (size_t)(n0 + n) * 1024 + k0 + kc * 8) = o;
    }
    __syncthreads();
}
DEVI void convert_flat(const float* src, bf16* dst, size_t n  ) {
    size_t gt = (size_t)blockIdx.x * 256 + opaque_tid(), gs = (size_t)gridDim.x * 256;
    for (size_t i = gt * 8; i < n; i += gs * 8) {
        f32x4 a = *(const f32x4*)(src + i), b = *(const f32x4*)(src + i + 4);
        *(uint4*)(dst + i) = make_uint4(pack2(a[0], a[1]), pack2(a[2], a[3]), pack2(b[0], b[1]), pack2(b[2], b[3]));
    }
}
template <bool I8>
DEVI void convert_rows_q8(const float* src, unsigned char* dst, float* scales, int nrows) {
    const int tid_ = opaque_tid(); const int lane = tid_ & 63, wave = tid_ >> 6;
    for (int r = blockIdx.x * 4 + wave; r < nrows; r += gridDim.x * 4) {
        const float* sr = src + (size_t)r * 1024 + 16 * lane;
        f32x4 a[4];
#pragma unroll
        for (int j = 0; j < 4; ++j) a[j] = *(const f32x4*)(sr + 4 * j);
        float am = 0.f;
#pragma unroll
        for (int j = 0; j < 4; ++j) am = fmaxf(fmaxf(fmaxf(am, fabsf(a[j][0])), fmaxf(fabsf(a[j][1]), fabsf(a[j][2]))), fabsf(a[j][3]));
#pragma unroll
        for (int o = 32; o >= 1; o >>= 1) am = fmaxf(am, __shfl_xor(am, o));
        float scale = am > 0.f ? am * (I8 ? 1.f / 127.f : 1.f / 448.f) : 1.f;
        float inv = 1.f / scale;
        unsigned w[4];
#pragma unroll
        for (int j = 0; j < 4; ++j) {
            if (I8) w[j] = pack_i8x4(a[j][0] * inv, a[j][1] * inv, a[j][2] * inv, a[j][3] * inv);
            else {
                int r0 = 0;
                r0 = __builtin_amdgcn_cvt_pk_fp8_f32(a[j][0] * inv, a[j][1] * inv, r0, false);
                r0 = __builtin_amdgcn_cvt_pk_fp8_f32(a[j][2] * inv, a[j][3] * inv, r0, true);
                w[j] = (unsigned)r0;
            }
        }
        {
            const int layer = r >> 14, e = r & 16383;
            *(uint4*)(dst + (((size_t)layer * 8 + (lane >> 3)) * 16384 + e) * 128 + 16 * (lane & 7)) = make_uint4(w[0], w[1], w[2], w[3]);
        }
        if (lane == 0) scales[r] = scale;
    }
}
DEVI void phase_convert(const Params& p, unsigned char* smem) {
    float* tile = (float*)smem;
    {
        const int n_win = 4 * 56 * 16, n_sq = 4 * 16 * 16;
        for (int item = blockIdx.x; item < n_win + 2 * n_sq; item += gridDim.x) {
            if (item < n_win) {
                int l = item / (56 * 16), r = item % (56 * 16);
                int nt = r / 16, kt = r % 16;
                transpose_tile(p.in[12] + (size_t)l * 1024 * 3488, 3488, (bf16*)(p.ws + OFF_WIN) + (size_t)l * WIN_ROWS * 1024, nt * 64, kt * 64, 0, tile);
            } else {
                int it = item - n_win; int which = it / n_sq; it %= n_sq;
                int l = it / 256, r = it % 256; int nt = r / 16, kt = r % 16;
                const float* src = (which == 0 ? p.in[21] : p.in[22]) + (size_t)l * 1024 * 1024;
                bf16* dst = (bf16*)(p.ws + (which == 0 ? OFF_WOUT : OFF_WQ)) + (size_t)l * 1024 * 1024;
                transpose_tile(src, 1024, dst, nt * 64, kt * 64, 1, tile);
            }
        }
    }
    convert_rows_q8<true>(p.in[25], p.ws + OFF_PU, (float*)(p.ws + OFF_SU), 4 * 16384);
    convert_rows_q8<true>(p.in[26], p.ws + OFF_PV, (float*)(p.ws + OFF_SV), 4 * 16384);
    convert_flat(p.in[23], (bf16*)(p.ws + OFF_K1), (size_t)4 * 8 * 128 * 64);
    convert_flat(p.in[24], (bf16*)(p.ws + OFF_K2), (size_t)4 * 8 * 128 * 64);
    {
        const float* ck = p.in[2]; const float* cv = p.in[3];
        bf16* CKo = (bf16*)(p.ws + OFF_CK); bf16* CVo = (bf16*)(p.ws + OFF_CVT);
        size_t gt = (size_t)blockIdx.x * 256 + opaque_tid(), gs = (size_t)gridDim.x * 256;
        for (size_t i = gt; i < (size_t)96 * 256 * 8; i += gs) {
            int d8 = (int)(i & 7), key = (int)((i >> 3) & 255); size_t m = i >> 11;
            const float* src = ck + (m * 256 + key) * 64 + d8 * 8;
            f32x4 a = *(const f32x4*)src, b = *(const f32x4*)(src + 4);
            *(uint4*)(CKo + m * 16384 + kf_idx(key, d8 * 8)) = make_uint4(pack2(a[0], a[1]), pack2(a[2], a[3]), pack2(b[0], b[1]), pack2(b[2], b[3]));
        }
        for (size_t i = gt; i < (size_t)96 * 32 * 64; i += gs) {
            int dv = (int)(i & 63), k8 = (int)((i >> 6) & 31); size_t m = i >> 11;
            const float* src = cv + (m * 256 + k8 * 8) * 64 + dv;
            float v[8];
#pragma unroll
            for (int j = 0; j < 8; ++j) v[j] = src[j * 64];
            *(uint4*)(CVo + m * 16384 + vf_idx(k8 * 8, dv)) = make_uint4(pack2(v[0], v[1]), pack2(v[2], v[3]), pack2(v[4], v[5]), pack2(v[6], v[7]));
        }
    }
}
DEVI void phase_h1_layer0(const Params& p) {
    {
        const int tid_ = opaque_tid(); const int lane = tid_ & 63, wave = tid_ >> 6;
        const float* mod = (const float*)(p.ws + OFF_MOD);
        bf16* H = (bf16*)(p.ws + OFF_H);
        for (int g = blockIdx.x * 4 + wave; g < NTOK; g += gridDim.x * 4) {
            const float* xr = g < NPROMPT ? p.in[0] + (size_t)g * 1024 : p.in[1] + (size_t)(g - NPROMPT) * 1024;
            f32x4 x[4];
#pragma unroll
            for (int j = 0; j < 4; ++j) x[j] = *(const f32x4*)(xr + 4 * lane + 256 * j);
            const float* m = mod + (size_t)(0 * 5 + tok_modrow(g)) * 6144;
            norm_store_row(x, p.in[10], m + 1024, m, H + (size_t)g * 1024, lane);
        }
    }
}

template <int RT, int CT>
DEVI void gemm_tile_core(const bf16* __restrict__ RM, int r0, const bf16* __restrict__ CM, int c0, unsigned char* smem, f32x4 (&acc)[RT / 32][CT / 32], const int tid) {
    constexpr int NI = RT / 32, NJ = CT / 32, COFF = RT * 128, STAGE = (RT + CT) * 128;
    static_assert(2 * STAGE <= LDS_MAIN, "GEMM LDS stages");
    const int lane = tid & 63, wave = __builtin_amdgcn_readfirstlane(tid >> 6);
    const int wr = wave >> 1, wc = wave & 1;
#pragma unroll
    for (int i = 0; i < NI; ++i)
#pragma unroll
        for (int j = 0; j < NJ; ++j) acc[i][j] = (f32x4){0.f, 0.f, 0.f, 0.f};
    const int srow = lane >> 3, spc = lane & 7;
    const bf16* rsrc[NI]; const bf16* csrc[NJ];
#pragma unroll
    for (int i = 0; i < NI; ++i) {
        int row = 8 * (wave + 4 * i) + srow;
        rsrc[i] = RM + (size_t)(r0 + row) * 1024 + (spc ^ ((row >> 1) & 7)) * 8;
    }
#pragma unroll
    for (int i = 0; i < NJ; ++i) {
        int row = 8 * (wave + 4 * i) + srow;
        csrc[i] = CM + (size_t)(c0 + row) * 1024 + (spc ^ ((row >> 1) & 7)) * 8;
    }
    LAS unsigned char* lds = (LAS unsigned char*)smem;
#define GEMM_STAGE(ks_, buf_) do { \
        _Pragma("unroll") for (int i = 0; i < NI; ++i) \
            __builtin_amdgcn_global_load_lds((const unsigned*)(rsrc[i] + (ks_) * 64), (LAS unsigned*)(lds + (buf_) * STAGE + (wave + 4 * i) * 1024), 16, 0, 0); \
        _Pragma("unroll") for (int i = 0; i < NJ; ++i) \
            __builtin_amdgcn_global_load_lds((const unsigned*)(csrc[i] + (ks_) * 64), (LAS unsigned*)(lds + (buf_) * STAGE + COFF + (wave + 4 * i) * 1024), 16, 0, 0); \
        } while (0)
    const int g = lane >> 4, lr = lane & 15;
    GEMM_STAGE(0, 0);
    for (int ks = 0; ks < 16; ++ks) {
        asm volatile("s_waitcnt vmcnt(0)" ::: "memory");
        __syncthreads();
        if (ks + 1 < 16) GEMM_STAGE(ks + 1, (ks + 1) & 1);
        const unsigned char* cur = smem + (ks & 1) * STAGE;
#pragma unroll
        for (int kk = 0; kk < 2; ++kk) {
            bf16x8 af[NI], bfg[NJ];
#pragma unroll
            for (int i = 0; i < NI; ++i) {
                int row = wr * (RT / 2) + i * 16 + lr; int ch = (kk * 4 + g) ^ ((row >> 1) & 7);
                af[i] = *(const bf16x8*)(cur + row * 128 + (ch << 4));
            }
#pragma unroll
            for (int j = 0; j < NJ; ++j) {
                int row = wc * (CT / 2) + j * 16 + lr; int ch = (kk * 4 + g) ^ ((row >> 1) & 7);
                bfg[j] = *(const bf16x8*)(cur + COFF + row * 128 + (ch << 4));
            }
#pragma unroll
            for (int i = 0; i < NI; ++i)
#pragma unroll
                for (int j = 0; j < NJ; ++j) acc[i][j] = __builtin_amdgcn_mfma_f32_16x16x32_bf16(af[i], bfg[j], acc[i][j], 0, 0, 0);
        }
    }
    __syncthreads();
#undef GEMM_STAGE
}

constexpr int GT = 192;
constexpr int GMT = NTOK / GT;

DEVI void phase_zgemm(const Params& p, int l, unsigned char* smem) {
    const bf16* H = (const bf16*)(p.ws + OFF_H);
    const bf16* W = (const bf16*)(p.ws + OFF_WIN) + (size_t)l * WIN_ROWS * 1024;
    bf16* Z = (bf16*)(p.ws + OFF_Z);
    bf16* VTA = (bf16*)(p.ws + OFF_VTA); bf16* VTN = (bf16*)(p.ws + OFF_VTN);
    const int tid_ = opaque_tid(); const int lane = tid_ & 63, wave = tid_ >> 6, wr = wave >> 1, wc = wave & 1, g = lane >> 4, lr = lane & 15;
    for (int tile = blockIdx.x; tile < GMT * 28; tile += gridDim.x) {
        int mt = tile / 28, nt = tile % 28;
        if (nt < 22) {
            f32x4 acc[4][GT / 32];
            gemm_tile_core<128, GT>(W, nt * 128, H, mt * GT, smem, acc, tid_);
            if (nt < 6 || (nt >= 9 && nt < 15)) {
                const int segbase = nt < 3 ? ZC_QA : nt < 6 ? ZC_KA : nt < 12 ? ZC_QN : ZC_KN;
                bf16* seg = (bf16*)(p.ws + (nt < 3 ? OFF_QAF : nt < 6 ? OFF_KAF : nt < 12 ? OFF_QNF : OFF_KNF));
                const int nn0 = nt * 128 + wr * 64 - segbase;
                bf16* dstb = seg + (size_t)(nn0 >> 6) * NTOK * 64;
                const bool kout = nt >= 12;
#pragma unroll
                for (int j = 0; j < GT / 32; ++j) {
                    const int tok = mt * GT + wc * (GT / 2) + j * 16 + lr;
#pragma unroll
                    for (int i = 0; i < 4; ++i) {
                        const int d = i * 16 + 4 * g;
                        const f32x4 a = acc[i][j];
                        *(uint2*)(dstb + kf_idx(tok, d)) = make_uint2(pack2(a[0], a[1]), pack2(a[2], a[3]));
                        if (kout && tok < NPROMPT) {
                            const int b = tok >> 8, t = tok & 255, hh = nn0 >> 6;
                            *(f32x4*)(p.out + O_NK + ((((size_t)b * 4 + l) * 6 + hh) * 256 + t) * 64 + d) = a;
                        }
                    }
                }
            } else {
#pragma unroll
                for (int j = 0; j < GT / 32; ++j) {
                    const int tok = mt * GT + wc * (GT / 2) + j * 16 + lr;
                    bf16* zr = Z + (size_t)tok * ZW + nt * 128 + wr * 64 + 4 * g;
#pragma unroll
                    for (int i = 0; i < 4; ++i) {
                        const f32x4 a = acc[i][j];
                        *(uint2*)(zr + i * 16) = make_uint2(pack2(a[0], a[1]), pack2(a[2], a[3]));
                    }
                }
            }
        } else {
            f32x4 acc[GT / 32][4];
            gemm_tile_core<GT, 128>(H, mt * GT, W, nt * 128, smem, acc, tid_);
            const bool isn = nt >= 25;
            const int hh = (nt * 128 + wc * 64 - (isn ? 3200 : 2816)) >> 6;
            bf16* vth = (isn ? VTN : VTA) + (size_t)hh * NTOK * 64;
#pragma unroll
            for (int i = 0; i < GT / 32; ++i) {
                const int tok = mt * GT + wr * (GT / 2) + i * 16 + 4 * g;
                const bool vout = isn && tok < NPROMPT;
                float* ob = p.out + O_NV + ((((size_t)(tok >> 8) * 4 + l) * 6 + hh) * 256 + (tok & 255)) * 64;
#pragma unroll
                for (int j = 0; j < 4; ++j) {
                    const int d = j * 16 + lr;
                    const f32x4 a = acc[i][j];
                    *(uint2*)(vth + vf_idx(tok, d)) = make_uint2(pack2(a[0], a[1]), pack2(a[2], a[3]));
                    if (vout) { float* o = ob + d; o[0] = a[0]; o[64] = a[1]; o[128] = a[2]; o[192] = a[3]; }
                }
            }
        }
    }
}

DEVI void phase_outgemm(const Params& p, int l, unsigned char* smem) {
    const bf16* Y = (const bf16*)(p.ws + OFF_YMIX);
    const bf16* W = (const bf16*)(p.ws + OFF_WOUT) + (size_t)l * 1024 * 1024;
    float* xw = (float*)(p.ws + OFF_XW);
    const float* mod = (const float*)(p.ws + OFF_MOD);
    const int tid_ = opaque_tid(); const int lane = tid_ & 63, wave = tid_ >> 6, wr = wave >> 1, wc = wave & 1, g = lane >> 4, lr = lane & 15;
    for (int tile = blockIdx.x; tile < GMT * 8; tile += gridDim.x) {
        const int slot = (tile % (int)gridDim.x) >> 3, xg = tile & 7, rnd = tile / (int)gridDim.x;
        int mt = (gridDim.x == 512) ? (xg + 8 * (slot >> 3)) : tile / 8, nt = (gridDim.x == 512) ? (slot & 7) : tile % 8;
        (void)rnd;
        f32x4 acc[4][GT / 32];
        gemm_tile_core<128, GT>(W, nt * 128, Y, mt * GT, smem, acc, tid_);
#pragma unroll
        for (int j = 0; j < GT / 32; ++j) {
            int tok = mt * GT + wc * (GT / 2) + j * 16 + lr;
            const float* g1 = mod + (size_t)(l * 5 + tok_modrow(tok)) * 6144 + 2048;
#pragma unroll
            for (int i = 0; i < 4; ++i) {
                int n = nt * 128 + wr * 64 + i * 16 + 4 * g;
                f32x4 gg = *(const f32x4*)(g1 + n);
                float* xp = xw + (size_t)tok * 1024 + n;
                const float* xs = l == 0 ? (tok < NPROMPT ? p.in[0] + (size_t)tok * 1024 + n : p.in[1] + (size_t)(tok - NPROMPT) * 1024 + n) : xp;
                f32x4 xv = *(const f32x4*)xs;
                f32x4 a = acc[i][j];
                xv[0] += gg[0] * a[0]; xv[1] += gg[1] * a[1]; xv[2] += gg[2] * a[2]; xv[3] += gg[3] * a[3];
                *(f32x4*)xp = xv;
            }
        }
    }
}

DEVI void phase_norm2(const Params& p, int l) {
    const int tid_ = opaque_tid(); const int lane = tid_ & 63, wave = tid_ >> 6;
    const float* mod = (const float*)(p.ws + OFF_MOD);
    const float* xw = (const float*)(p.ws + OFF_XW); bf16* H = (bf16*)(p.ws + OFF_H);
    for (int g = blockIdx.x * 4 + wave; g < NTOK; g += gridDim.x * 4) {
        f32x4 x[4];
#pragma unroll
        for (int j = 0; j < 4; ++j) x[j] = *(const f32x4*)(xw + (size_t)g * 1024 + 4 * lane + 256 * j);
        const float* m = mod + (size_t)(l * 5 + tok_modrow(g)) * 6144;
        norm_store_row<true>(x, p.in[11] + l * 1024, m + 4096, m + 3072, H + (size_t)g * 1024, lane, p.ws + OFF_H8 + (size_t)g * 1024, (float*)(p.ws + OFF_SH8) + g);
    }
}

DEVI void phase_qgemm(const Params& p, int l, unsigned char* smem) {
    const bf16* H = (const bf16*)(p.ws + OFF_H);
    const bf16* W = (const bf16*)(p.ws + OFF_WQ) + (size_t)l * 1024 * 1024;
    bf16* QP = (bf16*)(p.ws + OFF_QP);
    const int tid_ = opaque_tid(); const int lane = tid_ & 63, wave = tid_ >> 6, wr = wave >> 1, wc = wave & 1, g = lane >> 4, lr = lane & 15;
    for (int tile = blockIdx.x; tile < GMT * 8; tile += gridDim.x) {
        const int slot = (tile % (int)gridDim.x) >> 3, xg = tile & 7, rnd = tile / (int)gridDim.x;
        int mt = (gridDim.x == 512) ? (xg + 8 * (slot >> 3)) : tile / 8, nt = (gridDim.x == 512) ? (slot & 7) : tile % 8;
        (void)rnd;
        f32x4 acc[4][GT / 32];
        gemm_tile_core<128, GT>(W, nt * 128, H, mt * GT, smem, acc, tid_);
#pragma unroll
        for (int i = 0; i < 4; ++i)
#pragma unroll
            for (int j = 0; j < GT / 32; ++j) {
                int n = nt * 128 + wr * 64 + i * 16 + 4 * g;
                int tok = mt * GT + wc * (GT / 2) + j * 16 + lr;
                f32x4 a = acc[i][j];
                *(uint2*)(QP + (size_t)tok * 1024 + n) = make_uint2(pack2(a[0], a[1]), pack2(a[2], a[3]));
            }
    }
}


DEVI void phase_gla_prep(const Params& p, int l, unsigned char* smem) {
    float* LR = (float*)smem;
    float* WA = (float*)(smem + 8448);
    float* BA = (float*)(smem + 16640);
    bf16* KS = (bf16*)(smem + 17152);
    float* CUM = (float*)(smem + 25600);
    const bf16* Z = (const bf16*)(p.ws + OFF_Z);
    const bf16* VTA = (const bf16*)(p.ws + OFF_VTA);
    bf16* QT = (bf16*)(p.ws + OFF_QT);
    float* OINTRA = (float*)(p.ws + OFF_OINTRA);
    float* UST = (float*)(p.ws + OFF_UST);
    float* DEC = (float*)(p.ws + OFF_DEC);
    const int tid = opaque_tid(), lane = tid & 63, w = tid >> 6, g = lane >> 4, lr = lane & 15;
    for (int item = blockIdx.x; item < NGITEM; item += gridDim.x) {
        const int cg = item / 6, h = item % 6, g0 = cg * 64;
        const int tloc = 16 * w + lr, tok = g0 + tloc;
        {
            int idx = tid * 8; int dir = idx >> 10, j = (idx >> 6) & 15, k = idx & 63;
            const float* src = (dir ? p.in[15] : p.in[13]) + (size_t)l * 16 * 384 + j * 384 + h * 64 + k;
            *(f32x4*)(WA + idx) = *(const f32x4*)src; *(f32x4*)(WA + idx + 4) = *(const f32x4*)(src + 4);
            if (tid < 128) { int dd = tid >> 6, kk = tid & 63; BA[tid] = (dd ? p.in[16] : p.in[14])[l * 384 + h * 64 + kk]; }
        }
        __syncthreads();
        {
            const int dir = w & 1;
            bf16x8 Af[2];
#pragma unroll
            for (int q = 0; q < 2; ++q) {
                const int t = 16 * (2 * (w >> 1) + q) + lr;
                uint4 v = make_uint4(0u, 0u, 0u, 0u);
                if (g < 2) v = *(const uint4*)(Z + (size_t)(g0 + t) * ZW + ZC_LRF + dir * 16 + 8 * g);
                Af[q] = mk_frag4(v.x, v.y, v.z, v.w);
            }
#pragma unroll
            for (int kt = 0; kt < 4; ++kt) {
                const int k = 16 * kt + lr;
                float wv[8];
#pragma unroll
                for (int jj = 0; jj < 8; ++jj) wv[jj] = g < 2 ? WA[(dir * 16 + 8 * g + jj) * 64 + k] : 0.f;
                const bf16x8 Bf = mk_frag4(pack2(wv[0], wv[1]), pack2(wv[2], wv[3]), pack2(wv[4], wv[5]), pack2(wv[6], wv[7]));
                const float bb = BA[dir * 64 + k];
#pragma unroll
                for (int q = 0; q < 2; ++q) {
                    f32x4 a = (f32x4){bb, bb, bb, bb};
                    a = __builtin_amdgcn_mfma_f32_16x16x32_bf16(Af[q], Bf, a, 0, 0, 0);
                    const int t0 = 16 * (2 * (w >> 1) + q) + 4 * g;
#pragma unroll
                    for (int e = 0; e < 4; ++e) CUM[(dir * 64 + t0 + e) * 64 + k] = log_sigmoid_f(a[e]) * (1.f / 16.f);
                }
            }
        }
        __syncthreads();
        if (tid < 128) {
            int dir = tid >> 6, k = tid & 63;
            float cv[64];
            float* cb = CUM + dir * 4096 + k;
#pragma unroll
            for (int t = 0; t < 64; ++t) cv[t] = cb[t * 64];
            float run = 0.f;
            if (dir == 0) {
#pragma unroll
                for (int t = 0; t < 64; ++t) { run += cv[t]; cv[t] = run; }
            } else {
#pragma unroll
                for (int t = 63; t >= 0; --t) { run += cv[t]; cv[t] = run; }
            }
#pragma unroll
            for (int t = 0; t < 64; ++t) cb[t * 64] = cv[t];
        }
        __syncthreads();
        uint4 qraw[2], kraw[4][2]; bf16x8 Vf[2];
        {
            const bf16* qaf = (const bf16*)(p.ws + OFF_QAF) + (size_t)h * NTOK * 64;
            const bf16* kaf0 = (const bf16*)(p.ws + OFF_KAF) + (size_t)h * NTOK * 64;
            const bf16* vta = VTA + (size_t)h * NTOK * 64;
#pragma unroll
            for (int kk = 0; kk < 2; ++kk) qraw[kk] = *(const uint4*)(qaf + kf_idx(tok, 32 * kk + 8 * g));
#pragma unroll
            for (int st = 0; st < 4; ++st) {
                const int s = 32 * (st >> 1) + 8 * (lr >> 2) + 4 * (st & 1) + (lr & 3);
#pragma unroll
                for (int kk = 0; kk < 2; ++kk) kraw[st][kk] = *(const uint4*)(kaf0 + kf_idx(g0 + s, 32 * kk + 8 * g));
            }
            Vf[0] = ld_frag(vta + vf_idx(g0 + 8 * g, 16 * w + lr));
            Vf[1] = ld_frag(vta + vf_idx(g0 + 32 + 8 * g, 16 * w + lr));
        }
        __builtin_amdgcn_sched_barrier(0);
        {
            f32x4 P[4];
#pragma unroll
            for (int st = 0; st < 4; ++st) P[st] = (f32x4){0.f, 0.f, 0.f, 0.f};
#pragma unroll 1
            for (int dir = 0; dir < 2; ++dir) {
                bf16x8 Qf[2], Kfr[4][2];
#pragma unroll
                for (int kk = 0; kk < 2; ++kk) {
                    int k0 = 32 * kk + 8 * g;
                    const uint4 q = qraw[kk];
                    const float* cp = CUM + (dir * 64 + tloc) * 64 + k0;
                    f32x4 c0 = *(const f32x4*)cp, c1 = *(const f32x4*)(cp + 4);
                    float v0 = bflo(q.x) * 0.125f * __expf(c0[0]), v1 = bfhi(q.x) * 0.125f * __expf(c0[1]);
                    float v2 = bflo(q.y) * 0.125f * __expf(c0[2]), v3 = bfhi(q.y) * 0.125f * __expf(c0[3]);
                    float v4 = bflo(q.z) * 0.125f * __expf(c1[0]), v5 = bfhi(q.z) * 0.125f * __expf(c1[1]);
                    float v6 = bflo(q.w) * 0.125f * __expf(c1[2]), v7 = bfhi(q.w) * 0.125f * __expf(c1[3]);
                    uint4 o = make_uint4(pack2(v0, v1), pack2(v2, v3), pack2(v4, v5), pack2(v6, v7));
                    *(uint4*)(QT + ((size_t)dir * 6 + h) * NTOK * 64 + kf_idx(tok, k0)) = o;
                    Qf[kk] = mk_frag4(o.x, o.y, o.z, o.w);
                }
#pragma unroll
                for (int st = 0; st < 4; ++st) {
                    int s = 32 * (st >> 1) + 8 * (lr >> 2) + 4 * (st & 1) + (lr & 3);
                    f32x4 T = (f32x4){0.f, 0.f, 0.f, 0.f};
#pragma unroll
                    for (int kk = 0; kk < 2; ++kk) {
                        int k0 = 32 * kk + 8 * g;
                        const uint4 q = kraw[st][kk];
                        const float* cp = CUM + (dir * 64 + s) * 64 + k0;
                        f32x4 c0 = *(const f32x4*)cp, c1 = *(const f32x4*)(cp + 4);
                        float v0 = bflo(q.x) * __expf(-c0[0]), v1 = bfhi(q.x) * __expf(-c0[1]);
                        float v2 = bflo(q.y) * __expf(-c0[2]), v3 = bfhi(q.y) * __expf(-c0[3]);
                        float v4 = bflo(q.z) * __expf(-c1[0]), v5 = bfhi(q.z) * __expf(-c1[1]);
                        float v6 = bflo(q.w) * __expf(-c1[2]), v7 = bfhi(q.w) * __expf(-c1[3]);
                        bf16x8 Kf = mk_frag4(pack2(v0, v1), pack2(v2, v3), pack2(v4, v5), pack2(v6, v7));
                        Kfr[st][kk] = Kf;
                        T = __builtin_amdgcn_mfma_f32_16x16x32_bf16(Kf, Qf[kk], T, 0, 0, 0);
                    }
#pragma unroll
                    for (int e = 0; e < 4; ++e) {
                        int sp = 32 * (st >> 1) + 8 * g + 4 * (st & 1) + e;
                        bool valid = dir == 0 ? (sp <= tloc) : (sp >= tloc);
                        P[st][e] += valid ? T[e] : 0.f;
                    }
                }
#pragma unroll
                for (int kt = 0; kt < 4; ++kt) {
                    const int k = 16 * kt + lr;
                    const float el = __expf(dir == 0 ? CUM[(0 * 64 + 63) * 64 + k] : CUM[(1 * 64 + 0) * 64 + k]);
                    unsigned sw[4];
#pragma unroll
                    for (int q = 0; q < 4; ++q) {
                        const int j0 = 8 * g + 2 * q - 16 * (kt & 1);
                        sw[q] = (j0 == lr ? 0x3F80u : 0u) | (j0 + 1 == lr ? 0x3F800000u : 0u);
                    }
                    const bf16x8 Sel = mk_frag4(sw[0], sw[1], sw[2], sw[3]);
                    f32x4 U = (f32x4){0.f, 0.f, 0.f, 0.f};
#pragma unroll
                    for (int G = 0; G < 2; ++G) {
                        f32x4 D0 = (f32x4){0.f, 0.f, 0.f, 0.f}, D1 = (f32x4){0.f, 0.f, 0.f, 0.f};
                        D0 = __builtin_amdgcn_mfma_f32_16x16x32_bf16(Kfr[2 * G][kt >> 1], Sel, D0, 0, 0, 0);
                        D1 = __builtin_amdgcn_mfma_f32_16x16x32_bf16(Kfr[2 * G + 1][kt >> 1], Sel, D1, 0, 0, 0);
                        const bf16x8 Kb = mk_frag4(pack2(D0[0], D0[1]), pack2(D0[2], D0[3]), pack2(D1[0], D1[1]), pack2(D1[2], D1[3]));
                        U = __builtin_amdgcn_mfma_f32_16x16x32_bf16(Vf[G], Kb, U, 0, 0, 0);
                    }
                    float* up = UST + (((size_t)item * 2 + dir) * 64 + 16 * w + 4 * g) * 64 + k;
                    up[0] = U[0] * el; up[64] = U[1] * el; up[128] = U[2] * el; up[192] = U[3] * el;
                }
            }
            bf16x8 vfr[4][2];
            {
                const bf16* vta = VTA + (size_t)h * NTOK * 64;
#pragma unroll
                for (int vt = 0; vt < 4; ++vt)
#pragma unroll
                    for (int kk = 0; kk < 2; ++kk) vfr[vt][kk] = ld_frag(vta + vf_idx(g0 + 32 * kk + 8 * g, 16 * vt + lr));
            }
            bf16x8 Pf[2];
#pragma unroll
            for (int kk = 0; kk < 2; ++kk)
                Pf[kk] = mk_frag4(pack2(P[2 * kk][0], P[2 * kk][1]), pack2(P[2 * kk][2], P[2 * kk][3]),
                                  pack2(P[2 * kk + 1][0], P[2 * kk + 1][1]), pack2(P[2 * kk + 1][2], P[2 * kk + 1][3]));
#pragma unroll
            for (int vt = 0; vt < 4; ++vt) {
                f32x4 O = (f32x4){0.f, 0.f, 0.f, 0.f};
#pragma unroll
                for (int kk = 0; kk < 2; ++kk) {
                    O = __builtin_amdgcn_mfma_f32_16x16x32_bf16(vfr[vt][kk], Pf[kk], O, 0, 0, 0);
                }
                *(f32x4*)(OINTRA + (size_t)tok * 384 + h * 64 + 16 * vt + 4 * g) = O;
            }
        }
        if (tid < 128) {
            int dir = tid >> 6, k = tid & 63;
            float last = dir == 0 ? CUM[(0 * 64 + 63) * 64 + k] : CUM[(1 * 64 + 0) * 64 + k];
            DEC[((size_t)item * 2 + dir) * 64 + k] = __expf(last);
        }
        __syncthreads();
    }
}

DEVI void phase_scan(const Params& p, int l) {
    const float* UST = (const float*)(p.ws + OFF_UST);
    const float* DEC = (const float*)(p.ws + OFF_DEC);
    bf16* SST = (bf16*)(p.ws + OFF_SST);
    const int tid = opaque_tid();
    for (int item = blockIdx.x; item < 960; item += gridDim.x) {
        int part = item & 3, dir = (item >> 2) & 1, sh = item >> 3, h = sh % 6, seq = sh / 6;
        int cbase = seq < 16 ? seq * 4 : 64 + (seq - 16) * 32, nc = seq < 16 ? 4 : 32;
        int e4 = part * 256 + tid, v = e4 >> 4, k4 = (e4 & 15) * 4;
        float S[4] = {0.f, 0.f, 0.f, 0.f};
        if (seq >= 16) {
            const float* st = (dir ? p.in[5] : p.in[4]) + ((((size_t)(seq - 16) * 4 + l) * 6 + h) * 64) * 64;
#pragma unroll
            for (int i = 0; i < 4; ++i) S[i] = st[(k4 + i) * 64 + v];
        }
        for (int ci = 0; ci < nc; ++ci) {
            int c = dir == 0 ? ci : nc - 1 - ci;
            size_t gi = (size_t)(cbase + c) * 6 + h;
            size_t eo = ((gi * 2 + dir) * 64 + v) * 64 + k4;
            *(uint2*)(SST + (gi * 2 + dir) * 4096 + kf_idx(v, k4)) = make_uint2(pack2(S[0], S[1]), pack2(S[2], S[3]));
            f32x4 U = *(const f32x4*)(UST + eo);
            f32x4 d = *(const f32x4*)(DEC + (gi * 2 + dir) * 64 + k4);
#pragma unroll
            for (int i = 0; i < 4; ++i) S[i] = d[i] * S[i] + U[i];
        }
        if (seq < 16) {
            float* o = p.out + (dir ? O_GB : O_GF) + ((((size_t)seq * 4 + l) * 6 + h) * 64) * 64;
#pragma unroll
            for (int i = 0; i < 4; ++i) o[(k4 + i) * 64 + v] = S[i];
        }
    }
}

struct AttnFr { bf16x8 k[4][2]; bf16x8 v[4][2]; };
struct AttnDesc { const bf16* kbase; const bf16* vbase; int kg[2]; int dri[2]; int kc0[2]; int win; };

DEVI AttnDesc attn_make_desc(int c, bool samp, const bf16* kb_ctx, const bf16* vb_ctx, const bf16* kb_tok, const bf16* vb_tok,
                             int seqbase, int rs, int kcw, int r) {
    AttnDesc d;
    const bool ctx = samp && c < 4;
    const bool win = samp && c >= 4;
    d.kbase = ctx ? kb_ctx : kb_tok;
    d.vbase = ctx ? vb_ctx : vb_tok;
    d.win = win ? 1 : 0;
    const int kr0 = rs + 2 * (c - 4), kr1 = kr0 + 1;
    const int base = ctx ? 0 : seqbase;
    d.kg[0] = win ? seqbase + kr0 * 64 + kcw : base + 64 * c;
    d.kg[1] = win ? seqbase + kr1 * 64 + kcw : base + 64 * c + 32;
    d.dri[0] = win ? kr0 - r + 7 : 0; d.dri[1] = win ? kr1 - r + 7 : 0;
    d.kc0[0] = d.kc0[1] = win ? kcw : 0;
    return d;
}
DEVI void attn_load(const AttnDesc& d, int g, int lr, AttnFr& f) {
    const int klane = (lr >> 2) * 512 + g * 32 + (lr & 3) * 8;
    const int vlane = g * 512 + lr * 8;
#pragma unroll
    for (int grp = 0; grp < 2; ++grp) {
        const bf16* kp = d.kbase + (size_t)d.kg[grp] * 64 + klane;
        const bf16* vp = d.vbase + (size_t)d.kg[grp] * 64 + vlane;
#pragma unroll
        for (int T = 0; T < 2; ++T) {
            f.k[2 * grp + T][0] = ld_frag(kp + T * 128);
            f.k[2 * grp + T][1] = ld_frag(kp + T * 128 + 256);
        }
#pragma unroll
        for (int vt = 0; vt < 4; ++vt) f.v[vt][grp] = ld_frag(vp + vt * 128);
    }
}

DEVI void attn_compute(f32x4 (&O)[4], float& m, float& lsum, const bf16x8 (&Qf)[2], const AttnFr& f, const AttnDesc& d,
                       const float* rpbh, int qc, int g, int lr) {
    f32x4 S[4];
    float cm = -1e30f;
    const int cs = min(max(qc - 8, 0), 48);
#pragma unroll
    for (int ti = 0; ti < 4; ++ti) {
        f32x4 T = (f32x4){0.f, 0.f, 0.f, 0.f};
        T = __builtin_amdgcn_mfma_f32_16x16x32_bf16(f.k[ti][0], Qf[0], T, 0, 0, 0);
        T = __builtin_amdgcn_mfma_f32_16x16x32_bf16(f.k[ti][1], Qf[1], T, 0, 0, 0);
#pragma unroll
        for (int e = 0; e < 4; ++e) {
            float s = T[e] * 0.125f;
            int kc = d.kc0[ti >> 1] + 8 * g + 4 * (ti & 1) + e;
            bool valid = (d.win == 0) || (kc >= cs && kc < cs + 16);
            int dc = min(max(kc - qc, -15), 15) + 15;
            float bias = d.win ? rpbh[d.dri[ti >> 1] * 31 + dc] : 0.f;
            s = valid ? s + bias : -1e30f;
            T[e] = s; cm = fmaxf(cm, s);
        }
        S[ti] = T;
    }
    cm = fmaxf(cm, __shfl_xor(cm, 16)); cm = fmaxf(cm, __shfl_xor(cm, 32));
    float mn = fmaxf(m, cm);
    float alpha = __expf(m - mn);
    m = mn;
#pragma unroll
    for (int vt = 0; vt < 4; ++vt) { O[vt][0] *= alpha; O[vt][1] *= alpha; O[vt][2] *= alpha; O[vt][3] *= alpha; }
    float ps = 0.f;
#pragma unroll
    for (int ti = 0; ti < 4; ++ti)
#pragma unroll
        for (int e = 0; e < 4; ++e) { float s = S[ti][e]; float pv = s > -1e29f ? __expf(s - mn) : 0.f; S[ti][e] = pv; ps += pv; }
    lsum = lsum * alpha + ps;
    bf16x8 Pf[2];
#pragma unroll
    for (int kk = 0; kk < 2; ++kk)
        Pf[kk] = mk_frag4(pack2(S[2 * kk][0], S[2 * kk][1]), pack2(S[2 * kk][2], S[2 * kk][3]),
                          pack2(S[2 * kk + 1][0], S[2 * kk + 1][1]), pack2(S[2 * kk + 1][2], S[2 * kk + 1][3]));
#pragma unroll
    for (int vt = 0; vt < 4; ++vt)
#pragma unroll
        for (int kk = 0; kk < 2; ++kk)
            O[vt] = __builtin_amdgcn_mfma_f32_16x16x32_bf16(f.v[vt][kk], Pf[kk], O[vt], 0, 0, 0);
}

DEVI void phase_attn(const Params& p, int l, unsigned char* smem, int rep = 0) {
    float* RPB = (float*)smem;
    volatile int* CLAIM = (volatile int*)(smem + 4096);
    const bf16* Z = (const bf16*)(p.ws + OFF_Z);
    const bf16* VTN = (const bf16*)(p.ws + OFF_VTN);
    const bf16* CK = (const bf16*)(p.ws + OFF_CK);
    const bf16* CVT = (const bf16*)(p.ws + OFF_CVT);
    bf16* YMIX = (bf16*)(p.ws + OFF_YMIX);
    const int tid = opaque_tid(), lane = tid & 63, w = tid >> 6, g = lane >> 4, lr = lane & 15;
    unsigned* qcnt = (unsigned*)(p.ws + OFF_CTL + 16384) + (64 + l + 4 * rep) * 16;
    for (;;) {
        __syncthreads();
        if (tid == 0) CLAIM[0] = (int)xb_add(qcnt, 1u);
        __syncthreads();
        const int item = CLAIM[0];
        if (item >= 768 + 384) break;
        f32x4 O[4];
#pragma unroll
        for (int vt = 0; vt < 4; ++vt) O[vt] = (f32x4){0.f, 0.f, 0.f, 0.f};
        float m = -1e30f, lsum = 0.f;
        int qtok, h, nchunk, b, r = 0, seqbase, qc = 0, rs = 0, kcw = 0;
        if (item < 768) {
            b = item / 192; int r2 = item % 192; h = r2 / 32; r = r2 % 32;
            for (int i = tid; i < 465; i += 256) RPB[i] = p.in[20][((size_t)(l * 6 + h) * 15) * 31 + i];
            __syncthreads();
            seqbase = NPROMPT + b * 2048; qc = 16 * w + lr; qtok = seqbase + r * 64 + qc; nchunk = 8;
            rs = min(max(r - 4, 0), 24); kcw = min(max(16 * w - 8, 0), 32);
        } else {
            int it = item - 768; b = it / 24; int r2 = it % 24; h = r2 / 4; int qb = r2 % 4;
            seqbase = b * 256; qtok = seqbase + qb * 64 + 16 * w + lr; nchunk = 4;
        }
        const bool samp = item < 768;
        bf16x8 Qf[2];
        { const bf16* qb = (const bf16*)(p.ws + OFF_QNF) + (size_t)h * NTOK * 64; Qf[0] = ld_frag(qb + kf_idx(qtok, 8 * g)); Qf[1] = ld_frag(qb + kf_idx(qtok, 8 * g + 32)); }
        const bf16* kb_ctx = CK + (((size_t)b * 4 + l) * 6 + h) * 256 * 64;
        const bf16* vb_ctx = CVT + (((size_t)b * 4 + l) * 6 + h) * 64 * 256;
        const bf16* kb_tok = (const bf16*)(p.ws + OFF_KNF) + (size_t)h * NTOK * 64;
        const bf16* vb_tok = VTN + (size_t)h * NTOK * 64;
        AttnFr cur; { const AttnDesc d0 = attn_make_desc(0, samp, kb_ctx, vb_ctx, kb_tok, vb_tok, seqbase, rs, kcw, r); attn_load(d0, g, lr, cur); }
#pragma unroll 1
        for (int c = 0; c < nchunk; ++c) {
            AttnFr nxt; { const AttnDesc dn = attn_make_desc(min(c + 1, nchunk - 1), samp, kb_ctx, vb_ctx, kb_tok, vb_tok, seqbase, rs, kcw, r); attn_load(dn, g, lr, nxt); }
            __builtin_amdgcn_sched_barrier(0);
            const AttnDesc dc = attn_make_desc(c, samp, kb_ctx, vb_ctx, kb_tok, vb_tok, seqbase, rs, kcw, r);
            attn_compute(O, m, lsum, Qf, cur, dc, RPB, qc, g, lr);
            cur = nxt;
        }
        lsum += __shfl_xor(lsum, 16); lsum += __shfl_xor(lsum, 32);
        float inv = 1.f / lsum;
#pragma unroll
        for (int vt = 0; vt < 4; ++vt) {
            f32x4 o = O[vt];
            *(uint2*)(YMIX + (size_t)qtok * 1024 + 640 + h * 64 + 16 * vt + 4 * g) = make_uint2(pack2(o[0] * inv, o[1] * inv), pack2(o[2] * inv, o[3] * inv));
        }
    }
}

DEVI void phase_gla_out(const Params& p, int l) {
    const bf16* Z = (const bf16*)(p.ws + OFF_Z);
    const bf16* QT = (const bf16*)(p.ws + OFF_QT);
    const bf16* SST = (const bf16*)(p.ws + OFF_SST);
    const float* OINTRA = (const float*)(p.ws + OFF_OINTRA);
    bf16* YMIX = (bf16*)(p.ws + OFF_YMIX);
    const int tid = opaque_tid(), lane = tid & 63, w = tid >> 6, g = lane >> 4, lr = lane & 15;
    for (int item = blockIdx.x; item < NGITEM; item += gridDim.x) {
        const int cg = item / 6, h = item % 6, g0 = cg * 64;
        const int tok = g0 + 16 * w + lr;
        f32x4 O[4];
#pragma unroll
        for (int vt = 0; vt < 4; ++vt) O[vt] = *(const f32x4*)(OINTRA + (size_t)tok * 384 + h * 64 + 16 * vt + 4 * g);
#pragma unroll
        for (int dir = 0; dir < 2; ++dir)
#pragma unroll
            for (int kk = 0; kk < 2; ++kk) {
                bf16x8 Qf = ld_frag(QT + ((size_t)dir * 6 + h) * NTOK * 64 + kf_idx(tok, 32 * kk + 8 * g));
#pragma unroll
                for (int vt = 0; vt < 4; ++vt) {
                    bf16x8 Sf = ld_frag(SST + ((size_t)item * 2 + dir) * 4096 + kf_idx(16 * vt + lr, 32 * kk + 8 * g));
                    O[vt] = __builtin_amdgcn_mfma_f32_16x16x32_bf16(Sf, Qf, O[vt], 0, 0, 0);
                }
            }
        float ss = 0.f;
#pragma unroll
        for (int vt = 0; vt < 4; ++vt) ss += O[vt][0] * O[vt][0] + O[vt][1] * O[vt][1] + O[vt][2] * O[vt][2] + O[vt][3] * O[vt][3];
        ss += __shfl_xor(ss, 16); ss += __shfl_xor(ss, 32);
        float rstd = rsqrtf(ss * (1.f / 64.f) + EPS);
#pragma unroll
        for (int vt = 0; vt < 4; ++vt) {
            int n = h * 64 + 16 * vt + 4 * g;
            f32x4 wv = *(const f32x4*)(p.in[17] + l * 384 + n);
            uint2 gz = *(const uint2*)(Z + (size_t)tok * ZW + ZC_GA + n);
            float y0 = O[vt][0] * rstd * wv[0] * silu_f(bflo(gz.x));
            float y1 = O[vt][1] * rstd * wv[1] * silu_f(bfhi(gz.x));
            float y2 = O[vt][2] * rstd * wv[2] * silu_f(bflo(gz.y));
            float y3 = O[vt][3] * rstd * wv[3] * silu_f(bfhi(gz.y));
            *(uint2*)(YMIX + (size_t)tok * 1024 + n) = make_uint2(pack2(y0, y1), pack2(y2, y3));
        }
    }
    {
        const float* cw = p.in[18] + l * 3 * 256; const float* cbias = p.in[19] + l * 256;
        size_t gt = (size_t)blockIdx.x * 256 + tid, gs = (size_t)gridDim.x * 256;
        for (size_t idx = gt; idx < (size_t)NTOK * 32; idx += gs) {
            int tok = (int)(idx >> 5), c8 = (int)(idx & 31) * 8;
            int pos = tok < NPROMPT ? (tok & 255) : ((tok - NPROMPT) & 2047);
            int T = tok < NPROMPT ? 256 : 2048;
            const bf16* zr = Z + (size_t)tok * ZW;
            uint4 chc = *(const uint4*)(zr + ZC_CH + c8), ccc = *(const uint4*)(zr + ZC_CC + c8), cbb = *(const uint4*)(zr + ZC_CB + c8);
            uint4 chp = make_uint4(0, 0, 0, 0), ccp = chp, chn = chp, ccn = chp;
            if (pos > 0) { chp = *(const uint4*)(zr - ZW + ZC_CH + c8); ccp = *(const uint4*)(zr - ZW + ZC_CC + c8); }
            if (pos < T - 1) { chn = *(const uint4*)(zr + ZW + ZC_CH + c8); ccn = *(const uint4*)(zr + ZW + ZC_CC + c8); }
            const unsigned* a_chc = (const unsigned*)&chc; const unsigned* a_ccc = (const unsigned*)&ccc; const unsigned* a_cbb = (const unsigned*)&cbb;
            const unsigned* a_chp = (const unsigned*)&chp; const unsigned* a_ccp = (const unsigned*)&ccp;
            const unsigned* a_chn = (const unsigned*)&chn; const unsigned* a_ccn = (const unsigned*)&ccn;
            unsigned o[4];
#pragma unroll
            for (int q = 0; q < 4; ++q) {
                float r[2];
#pragma unroll
                for (int hf = 0; hf < 2; ++hf) {
                    int c = c8 + 2 * q + hf;
                    float up = hf ? bfhi(a_chp[q]) * bfhi(a_ccp[q]) : bflo(a_chp[q]) * bflo(a_ccp[q]);
                    float uc = hf ? bfhi(a_chc[q]) * bfhi(a_ccc[q]) : bflo(a_chc[q]) * bflo(a_ccc[q]);
                    float un = hf ? bfhi(a_chn[q]) * bfhi(a_ccn[q]) : bflo(a_chn[q]) * bflo(a_ccn[q]);
                    float bgate = hf ? bfhi(a_cbb[q]) : bflo(a_cbb[q]);
                    r[hf] = bgate * (cw[c] * up + cw[256 + c] * uc + cw[512 + c] * un + cbias[c]);
                }
                o[q] = pack2(r[0], r[1]);
            }
            *(uint4*)(YMIX + (size_t)tok * 1024 + 384 + c8) = make_uint4(o[0], o[1], o[2], o[3]);
        }
    }
}

typedef __attribute__((ext_vector_type(2))) __bf16 bf2v;
typedef __attribute__((ext_vector_type(2))) float f32x2;
DEVI float dot2bf(unsigned a, unsigned b, float c) {
    return __builtin_amdgcn_fdot2_f32_bf16(__builtin_bit_cast(bf2v, a), __builtin_bit_cast(bf2v, b), c, false);
}

#define FOR64(body) _Pragma("unroll") for (int rt = 0; rt < 4; ++rt) { _Pragma("unroll") for (int rg = 0; rg < 16; ++rg) { const float v = acc[rt][rg]; body } }

DEVI unsigned pk_sub_sat_u16(unsigned a, unsigned b) { unsigned d; asm("v_pk_sub_u16 %0, %1, %2 clamp" : "=v"(d) : "v"(a), "v"(b)); return d; }
DEVI unsigned pk_min_u16(unsigned a, unsigned b) { unsigned d; asm("v_pk_min_u16 %0, %1, %2" : "=v"(d) : "v"(a), "v"(b)); return d; }
DEVI unsigned pk_add_u16(unsigned a, unsigned b) { unsigned d; asm("v_pk_add_u16 %0, %1, %2" : "=v"(d) : "v"(a), "v"(b)); return d; }
template <int N> DEVI unsigned pk_count_gt(const unsigned (&kp)[N], unsigned t) {
    const unsigned t2 = t * 0x00010001u;
    unsigned c0 = 0u, c1 = 0u;
#pragma unroll
    for (int j = 0; j < N; j += 2) {
        c0 = pk_add_u16(c0, pk_min_u16(pk_sub_sat_u16(kp[j], t2), 0x00010001u));
        c1 = pk_add_u16(c1, pk_min_u16(pk_sub_sat_u16(kp[j + 1], t2), 0x00010001u));
    }
    const unsigned c = pk_add_u16(c0, c1);
    return (c & 0xffffu) + (c >> 16);
}
template <int N> DEVI void pk_select16(const unsigned (&kp)[N], unsigned& T, unsigned& cgt_own, unsigned& cge_own) {
    unsigned lo = 0u, hi = 65536u;
#pragma unroll 1
    for (int it = 0; it < 16; ++it) {
        const unsigned mid = (lo + hi) >> 1;
        unsigned c = pk_count_gt<N>(kp, mid - 1u);
        c += __shfl_xor(c, 32);
        const bool ge = c >= 16u;
        lo = ge ? mid : lo; hi = ge ? hi : mid;
    }
    T = lo;
    cgt_own = pk_count_gt<N>(kp, T);
    cge_own = T == 0u ? (unsigned)(2 * N) : pk_count_gt<N>(kp, T - 1u);
}
DEVI unsigned quant16(float v, float mn, float scale) { return (unsigned)__builtin_fminf(__builtin_fmaxf((v - mn) * scale + 0.5f, 0.f), 65535.f); }

DEVI void phase_peer_score(const Params& p, int l, unsigned char* smem) {
    const bf16* QP = (const bf16*)(p.ws + OFF_QP);
    int* PIDX = (int*)(p.ws + OFF_PIDX);
    float* PG = (float*)(p.ws + OFF_PG);
    f32x2* PGS = (f32x2*)(p.ws + OFF_PGS);
    const float* SUl = (const float*)(p.ws + OFF_SU) + (size_t)l * 16384;
    const float* SVl = (const float*)(p.ws + OFF_SV) + (size_t)l * 16384;
    const int tid = opaque_tid(), lane = tid & 63, w = tid >> 6, tl = lane & 31, hh = lane >> 5;
    float* LV = (float*)(smem + w * 12288);
    int* LI = (int*)(smem + w * 12288 + 4096);
    float* FV = (float*)(smem + w * 12288 + 8192);
    int* FI = (int*)(smem + w * 12288 + 10240);
    {
        f32x4* az = (f32x4*)(p.ws + OFF_ACT);
        float zz = 0.f; asm volatile("" : "+v"(zz));
        for (size_t i = (size_t)blockIdx.x * 256 + tid; i < (size_t)NTOK * 128 / 4; i += (size_t)gridDim.x * 256) az[i] = (f32x4){zz, zz, zz, zz};
    }
    for (int item = blockIdx.x; item < 768; item += gridDim.x) {
        const int tt = item >> 1, h = (item & 1) * 4 + w;
        const int tok = tt * 32 + tl;
        __builtin_amdgcn_wave_barrier();
#pragma unroll 1
        for (int side = 0; side < 2; ++side) {
            bf16x8 qfs[4], kfs[4][4];
            {
                const bf16* kb = (const bf16*)(p.ws + (side ? OFF_K2 : OFF_K1)) + ((size_t)(l * 8 + h) * 128) * 64;
#pragma unroll
                for (int ks = 0; ks < 4; ++ks) {
                    qfs[ks] = ld_frag(QP + (size_t)tok * 1024 + h * 128 + side * 64 + 16 * ks + 8 * hh);
#pragma unroll
                    for (int rt = 0; rt < 4; ++rt) kfs[ks][rt] = ld_frag(kb + (size_t)(32 * rt + tl) * 64 + 16 * ks + 8 * hh);
                }
            }
            __builtin_amdgcn_sched_barrier(0);
            f32x16 acc[4];
#pragma unroll
            for (int rt = 0; rt < 4; ++rt)
#pragma unroll
                for (int rg = 0; rg < 16; ++rg) acc[rt][rg] = 0.f;
#pragma unroll
            for (int ks = 0; ks < 4; ++ks)
#pragma unroll
                for (int rt = 0; rt < 4; ++rt) acc[rt] = __builtin_amdgcn_mfma_f32_32x32x16_bf16(kfs[ks][rt], qfs[ks], acc[rt], 0, 0, 0);
            float mx = -3e38f, mn = 3e38f;
            FOR64(mx = fmaxf(mx, v); mn = fminf(mn, v);)
            mx = fmaxf(mx, __shfl_xor(mx, 32)); mn = fminf(mn, __shfl_xor(mn, 32));
            const float scale = mx > mn ? 16777215.f / (mx - mn) : 0.f, koff = -mn * scale;
            const unsigned lowc = 127u - 4u * hh;
            unsigned K[64];
#pragma unroll
            for (int rt = 0; rt < 4; ++rt)
#pragma unroll
                for (int rg = 0; rg < 16; ++rg) {
                    const unsigned q = (unsigned)__builtin_fmaf(acc[rt][rg], scale, koff);
                    K[rt * 16 + rg] = (q << 7) | (lowc - (unsigned)(32 * rt + (rg & 3) + 8 * (rg >> 2)));
                }
#define CEU(a, b) { const unsigned h_ = max(K[a], K[b]), l_ = min(K[a], K[b]); K[a] = h_; K[b] = l_; }
#define SORT16(o) CEU(o+0,o+1) CEU(o+2,o+3) CEU(o+4,o+5) CEU(o+6,o+7) CEU(o+8,o+9) CEU(o+10,o+11) CEU(o+12,o+13) CEU(o+14,o+15) CEU(o+0,o+2) CEU(o+1,o+3) CEU(o+4,o+6) CEU(o+5,o+7) CEU(o+8,o+10) CEU(o+9,o+11) CEU(o+12,o+14) CEU(o+13,o+15) CEU(o+1,o+2) CEU(o+5,o+6) CEU(o+9,o+10) CEU(o+13,o+14) CEU(o+0,o+4) CEU(o+1,o+5) CEU(o+2,o+6) CEU(o+3,o+7) CEU(o+8,o+12) CEU(o+9,o+13) CEU(o+10,o+14) CEU(o+11,o+15) CEU(o+2,o+4) CEU(o+3,o+5) CEU(o+10,o+12) CEU(o+11,o+13) CEU(o+1,o+2) CEU(o+3,o+4) CEU(o+5,o+6) CEU(o+9,o+10) CEU(o+11,o+12) CEU(o+13,o+14) CEU(o+0,o+8) CEU(o+1,o+9) CEU(o+2,o+10) CEU(o+3,o+11) CEU(o+4,o+12) CEU(o+5,o+13) CEU(o+6,o+14) CEU(o+7,o+15) CEU(o+4,o+8) CEU(o+5,o+9) CEU(o+6,o+10) CEU(o+7,o+11) CEU(o+2,o+4) CEU(o+3,o+5) CEU(o+6,o+8) CEU(o+7,o+9) CEU(o+10,o+12) CEU(o+11,o+13) CEU(o+1,o+2) CEU(o+3,o+4) CEU(o+5,o+6) CEU(o+7,o+8) CEU(o+9,o+10) CEU(o+11,o+12) CEU(o+13,o+14)
#define BITONIC16(x) CEU(x+0,x+8) CEU(x+1,x+9) CEU(x+2,x+10) CEU(x+3,x+11) CEU(x+4,x+12) CEU(x+5,x+13) CEU(x+6,x+14) CEU(x+7,x+15) CEU(x+0,x+4) CEU(x+1,x+5) CEU(x+2,x+6) CEU(x+3,x+7) CEU(x+8,x+12) CEU(x+9,x+13) CEU(x+10,x+14) CEU(x+11,x+15) CEU(x+0,x+2) CEU(x+1,x+3) CEU(x+4,x+6) CEU(x+5,x+7) CEU(x+8,x+10) CEU(x+9,x+11) CEU(x+12,x+14) CEU(x+13,x+15) CEU(x+0,x+1) CEU(x+2,x+3) CEU(x+4,x+5) CEU(x+6,x+7) CEU(x+8,x+9) CEU(x+10,x+11) CEU(x+12,x+13) CEU(x+14,x+15)
#define MERGE16(x, y) { _Pragma("unroll") for (int i_ = 0; i_ < 16; ++i_) K[x + i_] = max(K[x + i_], K[y + 15 - i_]); BITONIC16(x) }
            SORT16(0) SORT16(16) SORT16(32) SORT16(48)
            MERGE16(0, 16) MERGE16(32, 48) MERGE16(0, 32)
            {
                unsigned P[16];
#pragma unroll
                for (int i = 0; i < 16; ++i) {
                    auto sw = __builtin_amdgcn_permlane32_swap(K[15 - i], K[15 - i], false, false);
                    P[i] = hh ? (unsigned)sw[0] : (unsigned)sw[1];
                }
#pragma unroll
                for (int i = 0; i < 16; ++i) K[i] = max(K[i], P[i]);
                BITONIC16(0)
            }
#undef MERGE16
#undef BITONIC16
#undef SORT16
#undef CEU
            {
                const float inv = mx > mn ? (mx - mn) * (1.f / 16777215.f) : 0.f;
                unsigned* dst = (unsigned*)(hh ? (void*)(LI + (side * 32 + tl) * 16) : (void*)(LV + (side * 32 + tl) * 16));
#pragma unroll
                for (int i = 0; i < 16; i += 4) {
                    unsigned o4[4];
#pragma unroll
                    for (int k = 0; k < 4; ++k) {
                        const unsigned key = K[i + k];
                        const float val = __builtin_fmaf((float)(key >> 7), inv, mn);
                        o4[k] = hh ? (127u - (key & 127u)) : __float_as_uint(val);
                    }
                    *(uint4*)(dst + i) = make_uint4(o4[0], o4[1], o4[2], o4[3]);
                }
            }
        }
        __builtin_amdgcn_wave_barrier();
        {
            float v1[16], v2[16];
#pragma unroll
            for (int a = 0; a < 16; ++a) v1[a] = LV[(0 * 32 + tl) * 16 + a];
#pragma unroll
            for (int b = 0; b < 16; ++b) v2[b] = LV[(1 * 32 + tl) * 16 + b];
            const float mx = v1[0] + v2[0];
            float mn = v1[15] + v2[0];
            mn = fminf(mn, v1[0] + v2[15]); mn = fminf(mn, v1[7] + v2[1]); mn = fminf(mn, v1[1] + v2[7]); mn = fminf(mn, v1[4] + v2[2]);
            mn = fminf(mn, v1[2] + v2[4]); mn = fminf(mn, v1[3] + v2[3]);
            const float scale = mx > mn ? 8388607.f / (mx - mn) : 0.f, koff = -mn * scale;
            unsigned K[32];
#define CAND(i, a0, b0, a1, b1) { const float cs_ = hh ? v1[a1] + v2[b1] : v1[a0] + v2[b0]; const unsigned q_ = (unsigned)__builtin_fmaf(cs_, scale, koff); \
                                  K[i] = (q_ << 8) | (hh ? (unsigned)(255 - (16 * a1 + b1)) : (unsigned)(255 - (16 * a0 + b0))); }
            CAND(0, 0, 0, 0, 1)
            CAND(1, 0, 2, 0, 3)
            CAND(2, 0, 4, 0, 5)
            CAND(3, 0, 6, 0, 7)
            CAND(4, 0, 8, 0, 9)
            CAND(5, 0, 10, 0, 11)
            CAND(6, 0, 12, 0, 13)
            CAND(7, 0, 14, 0, 15)
            CAND(8, 1, 0, 1, 1)
            CAND(9, 1, 2, 1, 3)
            CAND(10, 1, 4, 1, 5)
            CAND(11, 1, 6, 1, 7)
            CAND(12, 2, 0, 2, 1)
            CAND(13, 2, 2, 2, 3)
            CAND(14, 2, 4, 3, 0)
            CAND(15, 3, 1, 3, 2)
            CAND(16, 3, 3, 4, 0)
            CAND(17, 4, 1, 4, 2)
            CAND(18, 5, 0, 5, 1)
            CAND(19, 6, 0, 6, 1)
            CAND(20, 7, 0, 7, 1)
            CAND(21, 8, 0, 9, 0)
            CAND(22, 10, 0, 11, 0)
            CAND(23, 12, 0, 13, 0)
            CAND(24, 14, 0, 15, 0)
#undef CAND
#define CEU(a, b) { const unsigned h_ = max(K[a], K[b]), l_ = min(K[a], K[b]); K[a] = h_; K[b] = l_; }
            CEU(0,1) CEU(2,3) CEU(4,5) CEU(6,7) CEU(8,9) CEU(10,11) CEU(12,13) CEU(14,15) CEU(0,2) CEU(1,3) CEU(4,6) CEU(5,7) CEU(8,10) CEU(9,11) CEU(12,14) CEU(13,15) CEU(1,2) CEU(5,6) CEU(9,10) CEU(13,14) CEU(0,4) CEU(1,5) CEU(2,6) CEU(3,7) CEU(8,12) CEU(9,13) CEU(10,14) CEU(11,15) CEU(2,4) CEU(3,5) CEU(10,12) CEU(11,13) CEU(1,2) CEU(3,4) CEU(5,6) CEU(9,10) CEU(11,12) CEU(13,14) CEU(0,8) CEU(1,9) CEU(2,10) CEU(3,11) CEU(4,12) CEU(5,13) CEU(6,14) CEU(7,15) CEU(4,8) CEU(5,9) CEU(6,10) CEU(7,11) CEU(2,4) CEU(3,5) CEU(6,8) CEU(7,9) CEU(10,12) CEU(11,13) CEU(1,2) CEU(3,4) CEU(5,6) CEU(7,8) CEU(9,10) CEU(11,12) CEU(13,14)
#define CEV(a, b) CEU(16 + a, 16 + b)
            CEV(0,1) CEV(2,3) CEV(4,5) CEV(6,7) CEV(0,2) CEV(1,3) CEV(4,6) CEV(5,7) CEV(1,2) CEV(5,6) CEV(0,4) CEV(1,5) CEV(2,6) CEV(3,7) CEV(2,4) CEV(3,5) CEV(1,2) CEV(3,4) CEV(5,6) CEV(0,8) CEV(4,8) CEV(2,4) CEV(3,5) CEV(6,8) CEV(1,2) CEV(3,4) CEV(5,6) CEV(7,8)
#undef CEV
#define BITONIC16 CEU(0,8) CEU(1,9) CEU(2,10) CEU(3,11) CEU(4,12) CEU(5,13) CEU(6,14) CEU(7,15) CEU(0,4) CEU(1,5) CEU(2,6) CEU(3,7) CEU(8,12) CEU(9,13) CEU(10,14) CEU(11,15) CEU(0,2) CEU(1,3) CEU(4,6) CEU(5,7) CEU(8,10) CEU(9,11) CEU(12,14) CEU(13,15) CEU(0,1) CEU(2,3) CEU(4,5) CEU(6,7) CEU(8,9) CEU(10,11) CEU(12,13) CEU(14,15)
#pragma unroll
            for (int i = 7; i < 16; ++i) K[i] = max(K[i], K[16 + 15 - i]);
            BITONIC16
            {
                unsigned P[16];
#pragma unroll
                for (int i = 0; i < 16; ++i) {
                    auto sw = __builtin_amdgcn_permlane32_swap(K[15 - i], K[15 - i], false, false);
                    P[i] = hh ? (unsigned)sw[0] : (unsigned)sw[1];
                }
#pragma unroll
                for (int i = 0; i < 16; ++i) K[i] = max(K[i], P[i]);
                BITONIC16
            }
#undef BITONIC16
#undef CEU
            const float inv = mx > mn ? (mx - mn) * (1.f / 8388607.f) : 0.f;
            const float top = (float)(K[0] >> 8);
            float ex[16], sum = 0.f;
#pragma unroll
            for (int k = 0; k < 16; ++k) { ex[k] = __expf(((float)(K[k] >> 8) - top) * inv); sum += ex[k]; }
            const float rs = 1.f / sum;
            const float sh8t = ((const float*)(p.ws + OFF_SH8))[tok];
            const unsigned hsel = 0u - (unsigned)hh;
            int eo[8]; f32x2 go[8];
#pragma unroll
            for (int k = 0; k < 8; ++k) {
                const unsigned key = (hsel & K[8 + k]) | (~hsel & K[k]);
                const float gk = __uint_as_float((hsel & __float_as_uint(ex[8 + k])) | (~hsel & __float_as_uint(ex[k]))) * rs;
                const unsigned pos = 255u - (key & 255u);
                const int ei = LI[(0 * 32 + tl) * 16 + (pos >> 4)] * 128 + LI[(1 * 32 + tl) * 16 + (pos & 15u)];
                eo[k] = ei; go[k] = (f32x2){gk * SVl[ei], SUl[ei] * sh8t};
            }
            int* po = PIDX + (size_t)tok * 128 + h * 16 + 8 * hh;
            *(int4*)po = make_int4(eo[0], eo[1], eo[2], eo[3]); *(int4*)(po + 4) = make_int4(eo[4], eo[5], eo[6], eo[7]);
            f32x4* pg = (f32x4*)(PGS + (size_t)tok * 128 + h * 16 + 8 * hh);
#pragma unroll
            for (int k = 0; k < 4; ++k) pg[k] = (f32x4){go[2 * k][0], go[2 * k][1], go[2 * k + 1][0], go[2 * k + 1][1]};
        }
        __builtin_amdgcn_wave_barrier();
    }
}

#ifndef PEER_TCH_DEF
#define PEER_TCH_DEF 16
#endif
constexpr int PEER_TCH = PEER_TCH_DEF;
constexpr int PEER_NCH = NTOK / PEER_TCH;

DEVI void unpack_fp8x16(const uint4& w, float (&f)[16]) {
    const unsigned wv[4] = {w.x, w.y, w.z, w.w};
#pragma unroll
    for (int q = 0; q < 4; ++q) {
        f32x2 lo = __builtin_amdgcn_cvt_pk_f32_fp8((int)wv[q], false), hi = __builtin_amdgcn_cvt_pk_f32_fp8((int)wv[q], true);
        f[4 * q] = lo[0]; f[4 * q + 1] = lo[1]; f[4 * q + 2] = hi[0]; f[4 * q + 3] = hi[1];
    }
}

DEVI float dot_fp8x16(const uint4& w, const float (&h)[16]) {
    const unsigned wv[4] = {w.x, w.y, w.z, w.w};
    f32x2 s = (f32x2){0.f, 0.f};
#pragma unroll
    for (int q = 0; q < 4; ++q) {
        f32x2 lo = __builtin_amdgcn_cvt_pk_f32_fp8((int)wv[q], false), hi = __builtin_amdgcn_cvt_pk_f32_fp8((int)wv[q], true);
        s += lo * (f32x2){h[4 * q], h[4 * q + 1]};
        s += hi * (f32x2){h[4 * q + 2], h[4 * q + 3]};
    }
    return s[0] + s[1];
}
DEVI void fma_fp8x16(const uint4& w, float a, f32x2 (&acc)[8]) {
    const unsigned wv[4] = {w.x, w.y, w.z, w.w};
    const f32x2 a2 = (f32x2){a, a};
#pragma unroll
    for (int q = 0; q < 4; ++q) {
        f32x2 lo = __builtin_amdgcn_cvt_pk_f32_fp8((int)wv[q], false), hi = __builtin_amdgcn_cvt_pk_f32_fp8((int)wv[q], true);
        acc[2 * q] += a2 * lo; acc[2 * q + 1] += a2 * hi;
    }
}
template <int B0, int B1, int B2>
DEVI void reduce_scatter16(const float (&v)[16], int lane, float (&out)[2]) {
    float r8[8], r4[4];
    { const bool hi = (lane & B0) != 0;
#pragma unroll
      for (int j = 0; j < 8; ++j) { float send = hi ? v[j] : v[8 + j]; float keep = hi ? v[8 + j] : v[j]; r8[j] = keep + __shfl_xor(send, B0); } }
    { const bool hi = (lane & B1) != 0;
#pragma unroll
      for (int j = 0; j < 4; ++j) { float send = hi ? r8[j] : r8[4 + j]; float keep = hi ? r8[4 + j] : r8[j]; r4[j] = keep + __shfl_xor(send, B1); } }
    { const bool hi = (lane & B2) != 0;
#pragma unroll
      for (int j = 0; j < 2; ++j) { float send = hi ? r4[j] : r4[2 + j]; float keep = hi ? r4[2 + j] : r4[j]; out[j] = keep + __shfl_xor(send, B2); } }
}

template <int B0, int B1, int B2, typename T>
DEVI void reduce_scatter16_hi8(const T (&v)[16], int lane, T (&out)[2]) {
    T r8[8], r4[4];
    { const bool hi = (lane & B0) != 0;
#pragma unroll
      for (int j = 0; j < 8; ++j) { const int i = ((j >> 2) << 3) | (j & 3); T send = hi ? v[i] : v[i | 4]; T keep = hi ? v[i | 4] : v[i]; r8[j] = keep + __shfl_xor(send, B0); } }
    { const bool hi = (lane & B1) != 0;
#pragma unroll
      for (int j = 0; j < 4; ++j) { const int i = ((j >> 1) << 2) | (j & 1); T send = hi ? r8[i] : r8[i | 2]; T keep = hi ? r8[i | 2] : r8[i]; r4[j] = keep + __shfl_xor(send, B1); } }
    { const bool hi = (lane & B2) != 0;
#pragma unroll
      for (int j = 0; j < 2; ++j) { const int i = j << 1; T send = hi ? r4[i] : r4[i | 1]; T keep = hi ? r4[i | 1] : r4[i]; out[j] = keep + __shfl_xor(send, B2); } }
}

template <int CTRL> DEVI int dpp_i(int v) { return __builtin_amdgcn_update_dpp(0, v, CTRL, 0xF, 0xF, false); }
DEVI void reduce_scatter16_hi8_dpp(const int (&v)[16], int lane, int (&out)[2]) {
    int r8[8], r4[4];
    { const bool hi = (lane & 4) != 0;
#pragma unroll
      for (int j = 0; j < 8; ++j) { const int i = ((j >> 2) << 3) | (j & 3); int send = hi ? v[i] : v[i | 4]; int keep = hi ? v[i | 4] : v[i]; r8[j] = keep + dpp_i<0x141>(send); } }
    { const bool hi = (lane & 2) != 0;
#pragma unroll
      for (int j = 0; j < 4; ++j) { const int i = ((j >> 1) << 2) | (j & 1); int send = hi ? r8[i] : r8[i | 2]; int keep = hi ? r8[i | 2] : r8[i]; r4[j] = keep + dpp_i<0x4E>(send); } }
    { const bool hi = (lane & 1) != 0;
#pragma unroll
      for (int j = 0; j < 2; ++j) { const int i = j << 1; int send = hi ? r4[i] : r4[i | 1]; int keep = hi ? r4[i | 1] : r4[i]; out[j] = keep + dpp_i<0xB1>(send); } }
}
template <typename T>
DEVI void reduce_scatter16_swap(const T (&v)[16], int lane, T (&out)[2]) {
    T r8[8], r4[4];
#pragma unroll
    for (int j = 0; j < 8; ++j) {
        auto sw = __builtin_amdgcn_permlane32_swap(__builtin_bit_cast(unsigned, v[j]), __builtin_bit_cast(unsigned, v[8 + j]), false, false);
        r8[j] = __builtin_bit_cast(T, (unsigned)sw[0]) + __builtin_bit_cast(T, (unsigned)sw[1]);
    }
#pragma unroll
    for (int j = 0; j < 4; ++j) {
        auto sw = __builtin_amdgcn_permlane16_swap(__builtin_bit_cast(unsigned, r8[j]), __builtin_bit_cast(unsigned, r8[4 + j]), false, false);
        r4[j] = __builtin_bit_cast(T, (unsigned)sw[0]) + __builtin_bit_cast(T, (unsigned)sw[1]);
    }
    { const bool hi = (lane & 8) != 0;
#pragma unroll
      for (int j = 0; j < 2; ++j) { T send = hi ? r4[j] : r4[2 + j]; T keep = hi ? r4[2 + j] : r4[j];
          out[j] = keep + __builtin_bit_cast(T, __builtin_amdgcn_update_dpp(0, __builtin_bit_cast(int, send), 0x128, 0xF, 0xF, false)); } }
}

struct PeerHdrU { int idx0, idx1; uint4 h8; };
struct PeerHdrV { int idx0, idx1; f32x2 gs0, gs1; float act0, act1; };

DEVI void peer_u_load_hdr(const Params& p, int g, int pp, int lane, PeerHdrU& h) {
    const int* PIDX = (const int*)(p.ws + OFF_PIDX);
    h.idx0 = PIDX[(size_t)g * 128 + lane]; h.idx1 = PIDX[(size_t)g * 128 + 64 + lane];
    h.h8 = *(const uint4*)(p.ws + OFF_H8 + (size_t)g * 1024 + 128 * pp + 16 * (lane & 7));
}
DEVI void peer_u_body(const Params& p, int l, int g, int pp, int lane, const PeerHdrU& h) {
    const unsigned char* PU = p.ws + OFF_PU + ((size_t)l * 8 + pp) * 16384 * 128;
    const unsigned lo16 = 16u * (lane & 7);
    const int r = lane >> 3;
    uint4 w[16];
#pragma unroll
    for (int i = 0; i < 16; ++i) {
        int e = __shfl(i < 8 ? h.idx0 : h.idx1, (8 * i + r) & 63);
        w[i] = *(const uint4*)(PU + (((unsigned)e << 7) + lo16));
    }
    int s[16];
#pragma unroll
    for (int i = 0; i < 16; ++i) {
        int d = __builtin_amdgcn_sdot4((int)w[i].x, (int)h.h8.x, 0, false);
        d = __builtin_amdgcn_sdot4((int)w[i].y, (int)h.h8.y, d, false);
        d = __builtin_amdgcn_sdot4((int)w[i].z, (int)h.h8.z, d, false);
        s[i] = __builtin_amdgcn_sdot4((int)w[i].w, (int)h.h8.w, d, false);
    }
    int o[2];
    reduce_scatter16_hi8_dpp(s, lane, o);
    const int ia = lane & 7;
    int* ACT = (int*)(p.ws + OFF_ACT) + (size_t)g * 128;
    (void)__hip_atomic_fetch_add(ACT + 8 * ia + r, o[0], __ATOMIC_RELAXED, __HIP_MEMORY_SCOPE_AGENT);
    (void)__hip_atomic_fetch_add(ACT + 64 + 8 * ia + r, o[1], __ATOMIC_RELAXED, __HIP_MEMORY_SCOPE_AGENT);
}
DEVI void peer_v_load_hdr(const Params& p, int g, int lane, PeerHdrV& h) {
    const int* PIDX = (const int*)(p.ws + OFF_PIDX);
    const f32x2* PGS = (const f32x2*)(p.ws + OFF_PGS);
    const int* ACT = (const int*)(p.ws + OFF_ACT) + (size_t)g * 128;
    h.idx0 = PIDX[(size_t)g * 128 + lane]; h.idx1 = PIDX[(size_t)g * 128 + 64 + lane];
    h.gs0 = PGS[(size_t)g * 128 + lane]; h.gs1 = PGS[(size_t)g * 128 + 64 + lane];
    h.act0 = (float)ACT[lane]; h.act1 = (float)ACT[64 + lane];
}
template <int CTRL, int ROWMASK>
DEVI float dpp_f(float v) {
    return __builtin_bit_cast(float, __builtin_amdgcn_update_dpp(__builtin_bit_cast(int, v), __builtin_bit_cast(int, v), CTRL, ROWMASK, 0xF, false));
}
DEVI float gelu_tanh_fast(float x) {
    float y = 0.7978845608028654f * (x + 0.044715f * x * x * x);
    float e = __expf(2.f * y);
    float t = 1.f - 2.f * __builtin_amdgcn_rcpf(e + 1.f);
    return 0.5f * x * (1.f + t);
}
DEVI void peer_v_body(const Params& p, int l, int g, int pp, int lane, const PeerHdrV& h) {
    const unsigned char* PV = p.ws + OFF_PV + ((size_t)l * 8 + pp) * 16384 * 128;
    const unsigned lo16 = 16u * (lane & 7);
    const int r = lane >> 3;
    const float a0 = gelu_tanh_fast(h.act0 * h.gs0[1]) * h.gs0[0];
    const float a1 = gelu_tanh_fast(h.act1 * h.gs1[1]) * h.gs1[0];
    uint4 w[16];
#pragma unroll
    for (int i = 0; i < 16; ++i) {
        int e = __shfl(i < 8 ? h.idx0 : h.idx1, (8 * i + r) & 63);
        w[i] = *(const uint4*)(PV + (((unsigned)e << 7) + lo16));
    }
    float am = fmaxf(fabsf(a0), fabsf(a1));
    am = fmaxf(am, dpp_f<0xB1, 0xF>(am));
    am = fmaxf(am, dpp_f<0x4E, 0xF>(am));
    am = fmaxf(am, dpp_f<0x141, 0xF>(am));
    am = fmaxf(am, dpp_f<0x140, 0xF>(am));
    am = fmaxf(am, dpp_f<0x142, 0xA>(am));
    am = fmaxf(am, dpp_f<0x143, 0xC>(am));
    am = __builtin_bit_cast(float, __builtin_amdgcn_readlane(__builtin_bit_cast(int, am), 63));
    const float sa = am > 0.f ? am * (1.f / 127.f) : 1.f, inva = __builtin_amdgcn_rcpf(sa);
    const int col = 128 * pp + 16 * (lane & 7) + (lane & 8);
    const float* g2 = (const float*)(p.ws + OFF_MOD) + (size_t)(l * 5 + tok_modrow(g)) * 6144 + 5120 + col;
    float* xp = (float*)(p.ws + OFF_XW) + (size_t)g * 1024 + col;
    f32x4 x0 = __builtin_nontemporal_load((const f32x4*)xp), x1 = __builtin_nontemporal_load((const f32x4*)(xp + 4));
    const f32x4 g0 = *(const f32x4*)g2, g1 = *(const f32x4*)(g2 + 4);
    typedef int i32x4 __attribute__((ext_vector_type(4)));
    unsigned Pq[4];
    {
        unsigned p0 = (unsigned)(int)__builtin_rintf(a0 * inva) & 0xffu, p1 = (unsigned)(int)__builtin_rintf(a1 * inva) & 0xffu;
        p0 |= (unsigned)__builtin_amdgcn_update_dpp(0, (int)p0, 0x128, 0xF, 0xF, false) << 8;
        p1 |= (unsigned)__builtin_amdgcn_update_dpp(0, (int)p1, 0x128, 0xF, 0xF, false) << 8;
        p0 |= (unsigned)__shfl((int)p0, (lane + 16) & 63) << 16; p1 |= (unsigned)__shfl((int)p1, (lane + 16) & 63) << 16;
        const int rs = ((lane >> 4) << 1) | ((lane >> 2) & 1);
        Pq[0] = (unsigned)__shfl((int)p0, rs); Pq[1] = (unsigned)__shfl((int)p0, 32 + rs); Pq[2] = (unsigned)__shfl((int)p1, rs); Pq[3] = (unsigned)__shfl((int)p1, 32 + rs);
    }
    const unsigned bsh = 8u * (lane & 3), selz = 0x0c0c0c0cu & ~(0xffu << bsh);
    const unsigned sel0 = selz, sel1 = selz | (1u << bsh), sel2 = selz | (2u << bsh), sel3 = selz | (3u << bsh);
    i32x4 C[4];
#pragma unroll
    for (int c = 0; c < 4; ++c) C[c] = (i32x4){0, 0, 0, 0};
#pragma unroll
    for (int q = 0; q < 4; ++q) {
        const i32x4 A = (i32x4){(int)__builtin_amdgcn_perm(0u, Pq[q], sel0), (int)__builtin_amdgcn_perm(0u, Pq[q], sel1),
                                (int)__builtin_amdgcn_perm(0u, Pq[q], sel2), (int)__builtin_amdgcn_perm(0u, Pq[q], sel3)};
        C[0] = __builtin_amdgcn_mfma_i32_16x16x64_i8(A, (i32x4){(int)w[4 * q].x, (int)w[4 * q + 1].x, (int)w[4 * q + 2].x, (int)w[4 * q + 3].x}, C[0], 0, 0, 0);
        C[1] = __builtin_amdgcn_mfma_i32_16x16x64_i8(A, (i32x4){(int)w[4 * q].y, (int)w[4 * q + 1].y, (int)w[4 * q + 2].y, (int)w[4 * q + 3].y}, C[1], 0, 0, 0);
        C[2] = __builtin_amdgcn_mfma_i32_16x16x64_i8(A, (i32x4){(int)w[4 * q].z, (int)w[4 * q + 1].z, (int)w[4 * q + 2].z, (int)w[4 * q + 3].z}, C[2], 0, 0, 0);
        C[3] = __builtin_amdgcn_mfma_i32_16x16x64_i8(A, (i32x4){(int)w[4 * q].w, (int)w[4 * q + 1].w, (int)w[4 * q + 2].w, (int)w[4 * q + 3].w}, C[3], 0, 0, 0);
    }
    int v[16];
#pragma unroll
    for (int c = 0; c < 4; ++c)
#pragma unroll
        for (int rg = 0; rg < 4; ++rg) {
            auto sw = __builtin_amdgcn_permlane16_swap((unsigned)C[c][rg], (unsigned)C[c][rg], false, false);
            const int t = (lane & 8) ? (int)sw[1] : (int)sw[0];
            v[4 * c + rg] = t + dpp_i<0x128>(t);
        }
    const int hsel = -((lane >> 3) & 1);
    float o[8];
#pragma unroll
    for (int k = 0; k < 8; ++k) o[k] = sa * (float)((hsel & v[8 + k]) | (~hsel & v[k]));
#pragma unroll
    for (int k = 0; k < 4; ++k) { x0[k] += g0[k] * o[k]; x1[k] += g1[k] * o[4 + k]; }
    __builtin_nontemporal_store(x0, (f32x4*)xp); __builtin_nontemporal_store(x1, (f32x4*)(xp + 4));
}

template <int PASS>
DEVI void phase_peer_part(const Params& p, int l) {
    const int tid_ = opaque_tid(); const int lane = tid_ & 63;
    unsigned* cntbase = (unsigned*)(p.ws + OFF_CTL + 16384) + (size_t)((l * 2 + PASS) * 8) * 16;
    const int home = (int)(xb_xcc_id() & 7u);
#pragma unroll 1
    for (int step = 0; step < 8; ++step) {
        const int pp = (home + step) & 7;
        unsigned* cnt = cntbase + pp * 16;
        if (step > 0) { if (xb_ld(cnt) >= (unsigned)PEER_NCH) continue; }
        unsigned cv = 0u;
        if (lane == 0) cv = xb_add(cnt, 1u);
        unsigned c = (unsigned)__builtin_amdgcn_readfirstlane((int)cv);
        while (c < (unsigned)PEER_NCH) {
            unsigned nv = 0u;
            if (lane == 0) nv = xb_add(cnt, 1u);
            const int g0 = (int)c * PEER_TCH;
            if (PASS == 0) {
                PeerHdrU cur; peer_u_load_hdr(p, g0, pp, lane, cur);
#pragma unroll 1
                for (int t = 0; t < PEER_TCH; ++t) {
                    PeerHdrU nxt; peer_u_load_hdr(p, g0 + (t + 1 < PEER_TCH ? t + 1 : t), pp, lane, nxt);
                    peer_u_body(p, l, g0 + t, pp, lane, cur);
                    cur = nxt;
                }
            } else {
                PeerHdrV cur; peer_v_load_hdr(p, g0, lane, cur);
#pragma unroll 1
                for (int t = 0; t < PEER_TCH; ++t) {
                    PeerHdrV nxt; peer_v_load_hdr(p, g0 + (t + 1 < PEER_TCH ? t + 1 : t), lane, nxt);
                    peer_v_body(p, l, g0 + t, pp, lane, cur);
                    cur = nxt;
                }
            }
            c = (unsigned)__builtin_amdgcn_readfirstlane((int)nv);
        }
    }
}

DEVI void phase_norm_next(const Params& p, int l) {
    const int tid_ = opaque_tid(); const int lane = tid_ & 63, wave = tid_ >> 6;
    const float* mod = (const float*)(p.ws + OFF_MOD);
    const float* xw = (const float*)(p.ws + OFF_XW); bf16* H = (bf16*)(p.ws + OFF_H);
    for (int g = blockIdx.x * 4 + wave; g < NTOK; g += gridDim.x * 4) {
        f32x4 x[4];
#pragma unroll
        for (int j = 0; j < 4; ++j) x[j] = *(const f32x4*)(xw + (size_t)g * 1024 + 4 * lane + 256 * j);
        if (l < NLAYER - 1) {
            const float* m = mod + (size_t)((l + 1) * 5 + tok_modrow(g)) * 6144;
            norm_store_row(x, p.in[10] + (l + 1) * 1024, m + 1024, m, H + (size_t)g * 1024, lane);
        } else {
            float ss = 0.f;
#pragma unroll
            for (int j = 0; j < 4; ++j) ss += x[j][0] * x[j][0] + x[j][1] * x[j][1] + x[j][2] * x[j][2] + x[j][3] * x[j][3];
            ss = wave_sum(ss);
            float rstd = rsqrtf(ss * (1.f / 1024.f) + EPS);
#pragma unroll
            for (int j = 0; j < 4; ++j) {
                int c0 = 4 * lane + 256 * j;
                f32x4 w = *(const f32x4*)(p.in[27] + c0); f32x4 o;
                o[0] = x[j][0] * rstd * w[0]; o[1] = x[j][1] * rstd * w[1]; o[2] = x[j][2] * rstd * w[2]; o[3] = x[j][3] * rstd * w[3];
                *(f32x4*)(p.out + O_Y + (size_t)g * 1024 + c0) = o;
            }
        }
    }
}

#ifndef PH_MASK
#define PH_MASK 0xFFF
#endif
#define PH_ON(x) (((PH_MASK) >> (x)) & 1)
constexpr int PPL = 11;
constexpr int N_PHASES = 2 + PPL * NLAYER;
__global__ void __launch_bounds__(256, 2) fwd_megakernel(Params p) {
    __shared__ __attribute__((aligned(16))) unsigned char smem[LDS_BYTES];
    unsigned* st = (unsigned*)(p.ws + OFF_CTL + 24576) + 2 * blockIdx.x;
    XcdBarrier bar; bar.bar = (unsigned*)(p.ws + OFF_CTL); bar.x = 0; bar.st = st;
    const bool multi = (p.ph_hi - p.ph_lo) > 1;
    if (multi) bar = xcd_barrier_post((unsigned*)(p.ws + OFF_CTL), st);
    for (int ph = p.ph_lo; ph < p.ph_hi; ++ph) {
        if (ph == 0) { if (PH_ON(0)) { phase_mod(p, smem); __syncthreads(); phase_convert(p, smem); }
#if defined(REP_PHASE) && REP_PHASE == 100
            __syncthreads(); phase_mod(p, smem);
#endif
        }
        else if (ph == 1) { if (PH_ON(1)) phase_h1_layer0(p);
#if defined(REP_PHASE) && REP_PHASE == 101
            __syncthreads(); phase_convert(p, smem);
#endif
        }
        else {
            const int l = (ph - 2) / PPL, s = (ph - 2) % PPL;
#ifdef REP_PHASE
            if (s == REP_PHASE) {
                switch (s) {
                    case 0: phase_zgemm(p, l, smem); break;
                    case 1: phase_gla_prep(p, l, smem); break;
                    case 2: if (REP_SUB & 1) phase_scan(p, l); if (REP_SUB & 2) phase_attn(p, l, smem, 1); break;
                    case 3: phase_gla_out(p, l); break;
                    case 5: phase_norm2(p, l); break;
                    case 6: phase_qgemm(p, l, smem); break;
                    case 7: phase_peer_score(p, l, smem); break;
                    default: break;
                }
                __syncthreads();
            }
#endif
            switch (s) {
                case 0: if (PH_ON(2)) phase_zgemm(p, l, smem); break;
                case 1: if (PH_ON(3)) phase_gla_prep(p, l, smem); break;
                case 2: if (PH_ON(4)) phase_scan(p, l); if (PH_ON(5)) phase_attn(p, l, smem); break;
                case 3: if (PH_ON(6)) phase_gla_out(p, l); break;
                case 4: if (PH_ON(7)) phase_outgemm(p, l, smem); break;
                case 5: if (PH_ON(8)) phase_norm2(p, l); break;
                case 6: if (PH_ON(9)) phase_qgemm(p, l, smem); break;
                case 7: if (PH_ON(10)) phase_peer_score(p, l, smem); break;
                case 8: if (PH_ON(11)) phase_peer_part<0>(p, l); break;
                case 9: if (PH_ON(11)) phase_peer_part<1>(p, l); break;
                default: if (PH_ON(11)) phase_norm_next(p, l); break;
            }
        }
        if (ph + 1 < p.ph_hi) { xcd_barrier(bar);
#if defined(REP_PHASE) && REP_PHASE == 200
            xcd_barrier(bar);
#endif
        }
    }
}

extern "C" void kernel_launch(void* const* d_in, const int* in_sizes, int n_in, void* d_out, int out_size, void* d_ws, size_t ws_size, hipStream_t stream) {
    static int grid = 0;
    if (grid == 0) {
        int dev = 0, cus = 0, per_cu = 0;
        if (n_in != 28 || ws_size < WS_END) { fprintf(stderr, "kernel_launch: unexpected inputs (n_in %d, ws %zu, need %zu)\n", n_in, ws_size, (size_t)WS_END); grid = -1; return; }
        hipGetDevice(&dev);
        hipDeviceGetAttribute(&cus, hipDeviceAttributeMultiprocessorCount, dev);
        if (hipOccupancyMaxActiveBlocksPerMultiprocessor(&per_cu, (const void*)fwd_megakernel, 256, 0) != hipSuccess) per_cu = 0;
        (void)hipGetLastError();
        if (per_cu > 2) per_cu = 2;
        if (per_cu < 1) { fprintf(stderr, "kernel_launch: occupancy query returned %d\n", per_cu); grid = -1; return; }
        grid = cus * per_cu;
    }
    if (grid < 0) return;
    Params p{};
    for (int i = 0; i < 28; ++i) p.in[i] = (const float*)d_in[i];
    p.out = (float*)d_out; p.ws = (unsigned char*)d_ws;
#if MULTI_LAUNCH
    for (int ph = 0; ph < N_PHASES; ++ph) {
        p.ph_lo = ph; p.ph_hi = ph + 1;
        hipLaunchKernelGGL(fwd_megakernel, dim3(grid), dim3(256), 0, stream, p);
    }
#else
    hipMemsetAsync((char*)d_ws + OFF_CTL, 0, 32768, stream);
    p.ph_lo = 0; p.ph_hi = N_PHASES;
    hipLaunchKernelGGL(fwd_megakernel, dim3(grid), dim3(256), 0, stream, p);
#endif
}
```

```cpp
#include <hip/hip_runtime.h>
#include <cstdio>
#include <cstdint>
#include <cstddef>

#ifndef MULTI_LAUNCH
#define MULTI_LAUNCH 0
#endif

typedef unsigned short bf16;
typedef __attribute__((ext_vector_type(8))) short bf16x8;
typedef __attribute__((ext_vector_type(4))) float f32x4;
typedef __attribute__((ext_vector_type(16))) float f32x16;

#define DEVI __device__ __forceinline__
#define LAS __attribute__((address_space(3)))

constexpr int D = 1024;
constexpr int NTOK = 12288;
constexpr int NPROMPT = 4096;
constexpr int NLAYER = 4;
constexpr int ZW = 2816;
constexpr int ZC_QA = 0, ZC_KA = 384, ZC_GA = 768, ZC_QN = 1152, ZC_KN = 1536, ZC_CH = 1920, ZC_CB = 2176, ZC_CC = 2432,
              ZC_LRF = 2688, ZC_LRB = 2704;
constexpr int WIN_ROWS = 3584;
constexpr int NCHUNK = NTOK / 64;
constexpr int NGITEM = NCHUNK * 6;
constexpr float EPS = 1e-6f;

constexpr size_t O_Y = 0;
constexpr size_t O_NK = 12582912;
constexpr size_t O_NV = 18874368;
constexpr size_t O_GF = 25165824;
constexpr size_t O_GB = 26738688;

constexpr size_t al256(size_t x) { return (x + 255) & ~(size_t)255; }
constexpr size_t OFF_CTL = 0;
constexpr size_t OFF_MOD = 32768;
constexpr size_t OFF_WIN = al256(OFF_MOD + (size_t)4 * 5 * 6144 * 4);
constexpr size_t OFF_WOUT = al256(OFF_WIN + (size_t)4 * WIN_ROWS * 1024 * 2);
constexpr size_t OFF_WQ = al256(OFF_WOUT + (size_t)4 * 1024 * 1024 * 2);
constexpr size_t OFF_PU = al256(OFF_WQ + (size_t)4 * 1024 * 1024 * 2);
constexpr size_t OFF_PV = al256(OFF_PU + (size_t)4 * 16384 * 1024);
constexpr size_t OFF_SU = al256(OFF_PV + (size_t)4 * 16384 * 1024);
constexpr size_t OFF_SV = al256(OFF_SU + (size_t)4 * 16384 * 4);
constexpr size_t OFF_CK = al256(OFF_SV + (size_t)4 * 16384 * 4);
constexpr size_t OFF_CVT = al256(OFF_CK + (size_t)4 * 4 * 6 * 256 * 64 * 2);
constexpr size_t OFF_K1 = al256(OFF_CVT + (size_t)4 * 4 * 6 * 256 * 64 * 2);
constexpr size_t OFF_K2 = al256(OFF_K1 + (size_t)4 * 8 * 128 * 64 * 2);
constexpr size_t OFF_XW = al256(OFF_K2 + (size_t)4 * 8 * 128 * 64 * 2);
constexpr size_t OFF_H = al256(OFF_XW + (size_t)NTOK * 1024 * 4);
constexpr size_t OFF_Z = al256(OFF_H + (size_t)NTOK * 1024 * 2);
constexpr size_t OFF_VTA = al256(OFF_Z + (size_t)NTOK * ZW * 2);
constexpr size_t OFF_VTN = al256(OFF_VTA + (size_t)384 * NTOK * 2);
constexpr size_t OFF_QT = al256(OFF_VTN + (size_t)384 * NTOK * 2);
constexpr size_t OFF_OINTRA = al256(OFF_QT + (size_t)2 * NTOK * 384 * 2);
constexpr size_t OFF_UST = al256(OFF_OINTRA + (size_t)NTOK * 384 * 4);
constexpr size_t OFF_DEC = al256(OFF_UST + (size_t)NGITEM * 2 * 4096 * 4);
constexpr size_t OFF_SST = al256(OFF_DEC + (size_t)NGITEM * 2 * 64 * 4);
constexpr size_t OFF_YMIX = al256(OFF_SST + (size_t)NGITEM * 2 * 4096 * 2);
constexpr size_t OFF_QP = OFF_Z;
constexpr size_t OFF_PIDX = al256(OFF_QP + (size_t)NTOK * 1024 * 2);
constexpr size_t OFF_ACT = al256(OFF_PIDX + (size_t)NTOK * 128 * 4);
constexpr size_t OFF_PGS = al256(OFF_ACT + (size_t)NTOK * 128 * 4);
constexpr size_t OFF_H8 = al256(OFF_PGS + (size_t)NTOK * 128 * 8);
constexpr size_t OFF_SH8 = al256(OFF_H8 + (size_t)NTOK * 1024);
static_assert(OFF_SH8 + (size_t)NTOK * 4 <= OFF_Z + (size_t)NTOK * ZW * 2, "channel-mixer buffers must fit inside Z");
constexpr size_t OFF_PG = 0;
constexpr size_t OFF_QNF = al256(OFF_YMIX + (size_t)NTOK * 1024 * 2);
constexpr size_t OFF_KNF = al256(OFF_QNF + (size_t)6 * NTOK * 64 * 2);
constexpr size_t OFF_QAF = al256(OFF_KNF + (size_t)6 * NTOK * 64 * 2);
constexpr size_t OFF_KAF = al256(OFF_QAF + (size_t)6 * NTOK * 64 * 2);
constexpr size_t OFF_PART = al256(OFF_KAF + (size_t)6 * NTOK * 64 * 2);
constexpr size_t WS_END = al256(OFF_PART + 256);

constexpr int LDS_MAIN = 81920;
constexpr int LDS_BYTES = LDS_MAIN;

struct Params {
    const float* in[28];
    float* out;
    unsigned char* ws;
    int ph_lo, ph_hi;
};

typedef __bf16 hwbf2 __attribute__((ext_vector_type(2)));
typedef float hwf2 __attribute__((ext_vector_type(2)));
DEVI unsigned short f2bf(float f) { return __builtin_bit_cast(unsigned short, (__bf16)f); }
DEVI float bf2f(unsigned short h) { return __uint_as_float(((unsigned)h) << 16); }
DEVI unsigned pack2(float a, float b) { return __builtin_bit_cast(unsigned, __builtin_convertvector((hwf2){a, b}, hwbf2)); }
DEVI unsigned pack_i8x4(float a, float b, float c, float d) {
    const int ia = (int)__builtin_rintf(a), ib = (int)__builtin_rintf(b), ic = (int)__builtin_rintf(c), id = (int)__builtin_rintf(d);
    return ((unsigned)ia & 0xffu) | (((unsigned)ib & 0xffu) << 8) | (((unsigned)ic & 0xffu) << 16) | ((unsigned)id << 24);
}
DEVI float bflo(unsigned u) { return __uint_as_float(u << 16); }
DEVI float bfhi(unsigned u) { return __uint_as_float(u & 0xffff0000u); }
DEVI float silu_f(float x) { return x * __builtin_amdgcn_rcpf(1.f + __expf(-x)); }
DEVI float gelu_tanh_f(float x) {
    float y = 0.7978845608028654f * (x + 0.044715f * x * x * x);
    float e = __expf(2.f * y);
    float t = 1.f - 2.f / (e + 1.f);
    return 0.5f * x * (1.f + t);
}
DEVI float log_sigmoid_f(float x) { return fminf(x, 0.f) - 0.6931471805599453f * __builtin_amdgcn_logf(1.f + __expf(-fabsf(x))); }
DEVI float wave_sum(float v) {
#pragma unroll
    for (int o = 32; o >= 1; o >>= 1) v += __shfl_xor(v, o);
    return v;
}
DEVI bf16x8 ld_frag(const bf16* p) { return *(const bf16x8*)p; }
typedef __attribute__((ext_vector_type(4))) unsigned u32x4;
DEVI bf16x8 mk_frag(uint2 a, uint2 b) {
    u32x4 c = (u32x4){a.x, a.y, b.x, b.y}; return __builtin_bit_cast(bf16x8, c);
}
DEVI bf16x8 mk_frag4(unsigned a, unsigned b, unsigned c_, unsigned d) {
    u32x4 c = (u32x4){a, b, c_, d}; return __builtin_bit_cast(bf16x8, c);
}
DEVI size_t kf_idx(int tok, int d) { return ((((((size_t)(tok >> 3) * 2 + (d >> 5)) * 2 + ((tok >> 2) & 1)) * 4 + ((d >> 3) & 3)) * 4 + (tok & 3)) * 8) + (d & 7); }
DEVI size_t vf_idx(int tok, int dv) { return ((((size_t)(tok >> 3) * 4 + (dv >> 4)) * 16 + (dv & 15)) * 8) + (tok & 7); }
DEVI int opaque_tid() { int t = threadIdx.x; asm volatile("" : "+v"(t)); return t; }
DEVI int tok_modrow(int g) { return g < NPROMPT ? 0 : 1 + ((g - NPROMPT) >> 11); }

#define XB_TMO      128
#define XB_XCNT(j)  (256  + 64 * (j))
#define XB_XSUB(j)  (1280 + 64 * (j))
#define XB_XGEN(j)  (2304 + 64 * (j))
#define XB_TOP      3328
#define XB_TOPGEN   3392
#define XCD_BAR_WORDS 3456
#define XB_SPIN_CAP (1u << 22)
DEVI unsigned xb_ld(unsigned* p) { return __hip_atomic_load(p, __ATOMIC_RELAXED, __HIP_MEMORY_SCOPE_AGENT); }
DEVI unsigned xb_add(unsigned* p, unsigned v) { return __hip_atomic_fetch_add(p, v, __ATOMIC_RELAXED, __HIP_MEMORY_SCOPE_AGENT); }
DEVI unsigned xb_xcc_id() { return (unsigned)__builtin_amdgcn_s_getreg((3 << 11) | 20) & 0xFu; }
#define XB_SPIN(cond, bar) do { unsigned _sp = 0; while (cond) { __builtin_amdgcn_s_sleep(1); \
    if ((++_sp & 255u) == 0u) { if (xb_ld(&(bar)[XB_TMO])) break; if (_sp > XB_SPIN_CAP) { atomicAdd(&(bar)[XB_TMO], 1u); break; } } } } while (0)
struct XcdBarrier { unsigned* bar; unsigned x; unsigned nloc, nx; };
DEVI XcdBarrier xcd_barrier_post(unsigned* bar) {
    XcdBarrier b; b.bar = bar; b.x = xb_xcc_id(); b.nloc = 0u; b.nx = 0u;
    if (threadIdx.x == 0) (void)xb_add(&bar[XB_XCNT(b.x)], 1u);
    return b;
}
DEVI void xcd_barrier_complete(unsigned* bar, unsigned x, unsigned& nloc, unsigned& nx) {
    const unsigned G = gridDim.x * gridDim.y * gridDim.z;
    unsigned sum, cnt, mine, sp = 0u;
    for (;;) {
        sum = 0u; cnt = 0u; mine = 0u;
#pragma unroll
        for (unsigned j = 0; j < 16; ++j) { const unsigned c = xb_ld(&bar[XB_XCNT(j)]); sum += c; cnt += (c > 0u) ? 1u : 0u; mine = (j == x) ? c : mine; }
        if (sum == G) break;
        __builtin_amdgcn_s_sleep(1);
        if ((++sp & 255u) == 0u) { if (xb_ld(&bar[XB_TMO])) break; if (sp > XB_SPIN_CAP) { atomicAdd(&bar[XB_TMO], 1u); break; } }
    }
    nloc = mine > 0u ? mine : 1u; nx = cnt > 0u ? cnt : 1u;
}
DEVI void xcd_barrier(XcdBarrier& b) {
    asm volatile("s_waitcnt vmcnt(0)" ::: "memory");
    __syncthreads();
    if (b.nloc == 0u) {
        unsigned nloc, nx; xcd_barrier_complete(b.bar, b.x, nloc, nx);
        b.nloc = (unsigned)__builtin_amdgcn_readfirstlane((int)nloc); b.nx = (unsigned)__builtin_amdgcn_readfirstlane((int)nx);
    }
    if (threadIdx.x == 0) {
        unsigned* bar = b.bar;
        __builtin_amdgcn_s_waitcnt(0);
        const unsigned nloc = b.nloc, nx = b.nx;
        const unsigned old = xb_add(&bar[XB_XSUB(b.x)], 1u);
        const unsigned gen = old / nloc;
        if (old + 1u == (gen + 1u) * nloc) {
            __builtin_amdgcn_fence(__ATOMIC_RELEASE, "agent");
            asm volatile("s_waitcnt vmcnt(0)" ::: "memory");
            const unsigned og = xb_add(&bar[XB_TOP], 1u);
            const unsigned target = (og / nx + 1u) * nx;
            if (og + 1u != target) XB_SPIN((int)(xb_ld(&bar[XB_TOP]) - target) < 0, bar);
            (void)xb_add(&bar[XB_XGEN(b.x)], 1u);
            __builtin_amdgcn_fence(__ATOMIC_ACQUIRE, "agent");
        } else {
            XB_SPIN(xb_ld(&bar[XB_XGEN(b.x)]) == gen, bar);
            __builtin_amdgcn_fence(__ATOMIC_ACQUIRE, "agent");
            asm volatile("s_waitcnt vmcnt(0)" ::: "memory");
        }
    }
    __syncthreads();
}

DEVI void phase_mod(const Params& p, unsigned char* smem) {
    float* sv = (float*)smem;
    float* red = sv + 5 * 1024;
    const float* c = p.in[6]; const float* cctx = p.in[7];
    const float* w_ada = p.in[8]; const float* b_ada = p.in[9];
    float* mod = (float*)(p.ws + OFF_MOD);
    const int tid = opaque_tid();
    for (int i = tid; i < 5 * 1024; i += 256) {
        int r = i >> 10, k = i & 1023;
        float x = (r == 0) ? cctx[k] : c[(r - 1) * 1024 + k];
        sv[i] = silu_f(x);
    }
    __syncthreads();
    const int tx = tid & 63, ty = tid >> 6;
    for (int item = blockIdx.x; item < 4 * 96; item += gridDim.x) {
        int l = item / 96, cb = item % 96;
        int col = cb * 64 + tx;
        const float* w = w_ada + (size_t)l * 1024 * 6144 + col;
        float a0 = 0, a1 = 0, a2 = 0, a3 = 0, a4 = 0;
#pragma unroll 1
        for (int k0 = ty * 256; k0 < ty * 256 + 256; k0 += 32) {
            float wv[32];
#pragma unroll
            for (int u = 0; u < 32; ++u) wv[u] = w[(size_t)(k0 + u) * 6144];
            __builtin_amdgcn_sched_barrier(0);
#pragma unroll
            for (int u = 0; u < 32; u += 4) {
                const f32x4 s0 = *(const f32x4*)(sv + k0 + u), s1 = *(const f32x4*)(sv + 1024 + k0 + u), s2 = *(const f32x4*)(sv + 2048 + k0 + u);
                const f32x4 s3 = *(const f32x4*)(sv + 3072 + k0 + u), s4 = *(const f32x4*)(sv + 4096 + k0 + u);
#pragma unroll
                for (int e = 0; e < 4; ++e) { a0 += s0[e] * wv[u + e]; a1 += s1[e] * wv[u + e]; a2 += s2[e] * wv[u + e]; a3 += s3[e] * wv[u + e]; a4 += s4[e] * wv[u + e]; }
            }
        }
        red[(ty * 5 + 0) * 64 + tx] = a0; red[(ty * 5 + 1) * 64 + tx] = a1; red[(ty * 5 + 2) * 64 + tx] = a2;
        red[(ty * 5 + 3) * 64 + tx] = a3; red[(ty * 5 + 4) * 64 + tx] = a4;
        __syncthreads();
        if (ty == 0) {
            float bb = b_ada[l * 6144 + col];
#pragma unroll
            for (int r = 0; r < 5; ++r) {
                float s = red[(0 * 5 + r) * 64 + tx] + red[(1 * 5 + r) * 64 + tx] + red[(2 * 5 + r) * 64 + tx] + red[(3 * 5 + r) * 64 + tx];
                mod[((size_t)l * 5 + r) * 6144 + col] = s + bb;
            }
        }
        __syncthreads();
    }
}

struct ModVec { f32x4 ws[4], sh[4]; };
DEVI void load_modvec(ModVec& mv, const float* nw, const float* sc, const float* sh, int lane) {
#pragma unroll
    for (int j = 0; j < 4; ++j) {
        const int c0 = 4 * lane + 256 * j;
        const f32x4 w = *(const f32x4*)(nw + c0), s1 = *(const f32x4*)(sc + c0);
        mv.ws[j] = (f32x4){w[0] * (1.f + s1[0]), w[1] * (1.f + s1[1]), w[2] * (1.f + s1[2]), w[3] * (1.f + s1[3])};
        mv.sh[j] = *(const f32x4*)(sh + c0);
    }
}
DEVI void wave_rows(int wave, int& g0, int& g1) {
    const int nw = (int)gridDim.x * 4, rpw = (NTOK + nw - 1) / nw, wv = (int)blockIdx.x * 4 + wave;
    g0 = wv * rpw; g1 = g0 + rpw < NTOK ? g0 + rpw : NTOK;
}
template <bool Q8 = false>
DEVI void norm_store_row(const f32x4 (&x)[4], const ModVec& mv, bf16* hrow, int lane, unsigned char* h8row = nullptr, float* sh8 = nullptr) {
    float ss = 0.f;
#pragma unroll
    for (int j = 0; j < 4; ++j) ss += x[j][0] * x[j][0] + x[j][1] * x[j][1] + x[j][2] * x[j][2] + x[j][3] * x[j][3];
    ss = wave_sum(ss);
    float rstd = rsqrtf(ss * (1.f / 1024.f) + EPS);
    f32x4 hq[4]; float am = 0.f;
#pragma unroll
    for (int j = 0; j < 4; ++j) {
        int c0 = 4 * lane + 256 * j;
        float h0 = x[j][0] * rstd * mv.ws[j][0] + mv.sh[j][0];
        float h1 = x[j][1] * rstd * mv.ws[j][1] + mv.sh[j][1];
        float h2 = x[j][2] * rstd * mv.ws[j][2] + mv.sh[j][2];
        float h3 = x[j][3] * rstd * mv.ws[j][3] + mv.sh[j][3];
        *(uint2*)(hrow + c0) = make_uint2(pack2(h0, h1), pack2(h2, h3));
        if (Q8) { hq[j] = (f32x4){h0, h1, h2, h3}; am = fmaxf(fmaxf(fmaxf(am, fabsf(h0)), fmaxf(fabsf(h1), fabsf(h2))), fabsf(h3)); }
    }
    if (Q8) {
#pragma unroll
        for (int o = 32; o >= 1; o >>= 1) am = fmaxf(am, __shfl_xor(am, o));
        const float scale = am > 0.f ? am * (1.f / 127.f) : 1.f, inv = 1.f / scale;
#pragma unroll
        for (int j = 0; j < 4; ++j) *(unsigned*)(h8row + 4 * lane + 256 * j) = pack_i8x4(hq[j][0] * inv, hq[j][1] * inv, hq[j][2] * inv, hq[j][3] * inv);
        if (lane == 0) *sh8 = scale;
    }
}

DEVI int win_orig_col(int n) {
    if ((n >= 768 && n < 1152) || (n >= 1920 && n < 2816)) n = (n & ~63) | (n & 35) | ((n & 12) << 1) | ((n & 16) >> 2);
    if (n < 768) return n;
    if (n < 1152) return n - 768 + 1152;
    if (n < 1536) return n - 1152 + 2336;
    if (n < 1920) return n - 1536 + 2720;
    if (n < 2688) return n - 1920 + 1568;
    if (n < 2720) return n - 2688 + 1536;
    if (n < 2816) return -1;
    if (n < 3200) return n - 2816 + 768;
    return n - 3200 + 3104;
}
DEVI void transpose_tile(const float* src, int src_ld, bf16* dst, int n0, int k0, int kind, float* tile  ) {
    const int tid = opaque_tid();
    const int nn = tid & 63;
    int oc = kind == 0 ? win_orig_col(n0 + nn) : (n0 + nn);
    float tv[16];
#pragma unroll
    for (int i = 0; i < 16; ++i) {
        int kk = i * 4 + (tid >> 6);
        tv[i] = (oc >= 0) ? src[(size_t)(k0 + kk) * src_ld + oc] : 0.f;
    }
    __builtin_amdgcn_sched_barrier(0);
#pragma unroll
    for (int i = 0; i < 16; ++i) {
        int kk = i * 4 + (tid >> 6);
        tile[kk * 65 + nn] = tv[i];
    }
    __syncthreads();
#pragma unroll
    for (int i = 0; i < 2; ++i) {
        int n = (tid >> 3) + 32 * i, kc = tid & 7;
        float v[8];
#pragma unroll
        for (int j = 0; j < 8; ++j) v[j] = tile[(kc * 8 + j) * 65 + n];
        uint4 o = make_uint4(pack2(v[0], v[1]), pack2(v[2], v[3]), pack2(v[4], v[5]), pack2(v[6], v[7]));
        *(uint4*)(dst + (size_t)(n0 + n) * 1024 + k0 + kc * 8) = o;
    }
    __syncthreads();
}
DEVI void convert_flat(const float* src, bf16* dst, size_t n  ) {
    size_t gt = (size_t)blockIdx.x * 256 + opaque_tid(), gs = (size_t)gridDim.x * 256;
    for (size_t i = gt * 8; i < n; i += gs * 8) {
        f32x4 a = *(const f32x4*)(src + i), b = *(const f32x4*)(src + i + 4);
        *(uint4*)(dst + i) = make_uint4(pack2(a[0], a[1]), pack2(a[2], a[3]), pack2(b[0], b[1]), pack2(b[2], b[3]));
    }
}
template <bool I8, int NR>
DEVI void convert_rows_q8(const float* src, unsigned char* dst, float* scales, int r_lo, int r_hi, int lane) {
    for (int rb = r_lo; rb < r_hi; rb += NR) {
        f32x4 a[NR][4];
#pragma unroll
        for (int q = 0; q < NR; ++q)
#pragma unroll
            for (int j = 0; j < 4; ++j) a[q][j] = *(const f32x4*)(src + (size_t)(rb + q) * 1024 + 16 * lane + 4 * j);
        __builtin_amdgcn_sched_barrier(0);
#pragma unroll
        for (int q = 0; q < NR; ++q) {
            const int r = rb + q;
            float am = 0.f;
#pragma unroll
            for (int j = 0; j < 4; ++j) am = fmaxf(fmaxf(fmaxf(am, fabsf(a[q][j][0])), fmaxf(fabsf(a[q][j][1]), fabsf(a[q][j][2]))), fabsf(a[q][j][3]));
#pragma unroll
            for (int o = 32; o >= 1; o >>= 1) am = fmaxf(am, __shfl_xor(am, o));
            float scale = am > 0.f ? am * (I8 ? 1.f / 127.f : 1.f / 448.f) : 1.f;
            float inv = 1.f / scale;
            unsigned w[4];
#pragma unroll
            for (int j = 0; j < 4; ++j) {
                if (I8) w[j] = pack_i8x4(a[q][j][0] * inv, a[q][j][1] * inv, a[q][j][2] * inv, a[q][j][3] * inv);
                else {
                    int r0 = 0;
                    r0 = __builtin_amdgcn_cvt_pk_fp8_f32(a[q][j][0] * inv, a[q][j][1] * inv, r0, false);
                    r0 = __builtin_amdgcn_cvt_pk_fp8_f32(a[q][j][2] * inv, a[q][j][3] * inv, r0, true);
                    w[j] = (unsigned)r0;
                }
            }
            {
                const int layer = r >> 14, e = r & 16383;
                *(uint4*)(dst + (((size_t)layer * 8 + (lane >> 3)) * 16384 + e) * 128 + 16 * (lane & 7)) = make_uint4(w[0], w[1], w[2], w[3]);
            }
            if (lane == 0) scales[2 * r] = scale;
        }
    }
}
DEVI void phase_convert(const Params& p, unsigned char* smem) {
    float* tile = (float*)smem;
    {
        const int n_win = 4 * 56 * 16, n_sq = 4 * 16 * 16;
        for (int item = blockIdx.x; item < n_win + 2 * n_sq; item += gridDim.x) {
            if (item < n_win) {
                int l = item / (56 * 16), r = item % (56 * 16);
                int nt = r / 16, kt = r % 16;
                transpose_tile(p.in[12] + (size_t)l * 1024 * 3488, 3488, (bf16*)(p.ws + OFF_WIN) + (size_t)l * WIN_ROWS * 1024, nt * 64, kt * 64, 0, tile);
            } else {
                int it = item - n_win; int which = it / n_sq; it %= n_sq;
                int l = it / 256, r = it % 256; int nt = r / 16, kt = r % 16;
                const float* src = (which == 0 ? p.in[21] : p.in[22]) + (size_t)l * 1024 * 1024;
                bf16* dst = (bf16*)(p.ws + (which == 0 ? OFF_WOUT : OFF_WQ)) + (size_t)l * 1024 * 1024;
                transpose_tile(src, 1024, dst, nt * 64, kt * 64, 1, tile);
            }
        }
    }
    {
        const int tid_ = opaque_tid(); const int lane = tid_ & 63;
        unsigned* cnt = (unsigned*)(p.ws + OFF_CTL + 24576);
        unsigned cv = 0u;
        if (lane == 0) cv = xb_add(cnt, 1u);
        unsigned c = (unsigned)__builtin_amdgcn_readfirstlane((int)cv);
        while (c < 2u * 4096u) {
            unsigned nv = 0u;
            if (lane == 0) nv = xb_add(cnt, 1u);
            const int r0 = (int)(c & 4095u) * 16;
            if (c < 4096u) convert_rows_q8<true, 4>(p.in[25], p.ws + OFF_PU, (float*)(p.ws + OFF_SU), r0, r0 + 16, lane);
            else convert_rows_q8<true, 4>(p.in[26], p.ws + OFF_PV, (float*)(p.ws + OFF_SU) + 1, r0, r0 + 16, lane);
            c = (unsigned)__builtin_amdgcn_readfirstlane((int)nv);
        }
    }
    convert_flat(p.in[23], (bf16*)(p.ws + OFF_K1), (size_t)4 * 8 * 128 * 64);
    convert_flat(p.in[24], (bf16*)(p.ws + OFF_K2), (size_t)4 * 8 * 128 * 64);
    {
        const float* ck = p.in[2]; const float* cv = p.in[3];
        bf16* CKo = (bf16*)(p.ws + OFF_CK); bf16* CVo = (bf16*)(p.ws + OFF_CVT);
        size_t gt = (size_t)blockIdx.x * 256 + opaque_tid(), gs = (size_t)gridDim.x * 256;
        for (size_t i = gt; i < (size_t)96 * 256 * 8; i += gs) {
            int d8 = (int)(i & 7), key = (int)((i >> 3) & 255); size_t m = i >> 11;
            const float* src = ck + (m * 256 + key) * 64 + d8 * 8;
            f32x4 a = *(const f32x4*)src, b = *(const f32x4*)(src + 4);
            *(uint4*)(CKo + m * 16384 + kf_idx(key, d8 * 8)) = make_uint4(pack2(a[0], a[1]), pack2(a[2], a[3]), pack2(b[0], b[1]), pack2(b[2], b[3]));
        }
        for (size_t i = gt; i < (size_t)96 * 32 * 64; i += gs) {
            int dv = (int)(i & 63), k8 = (int)((i >> 6) & 31); size_t m = i >> 11;
            const float* src = cv + (m * 256 + k8 * 8) * 64 + dv;
            float v[8];
#pragma unroll
            for (int j = 0; j < 8; ++j) v[j] = src[j * 64];
            *(uint4*)(CVo + m * 16384 + vf_idx(k8 * 8, dv)) = make_uint4(pack2(v[0], v[1]), pack2(v[2], v[3]), pack2(v[4], v[5]), pack2(v[6], v[7]));
        }
    }
}
DEVI void phase_h1_layer0(const Params& p) {
    {
        const int tid_ = opaque_tid(); const int lane = tid_ & 63, wave = tid_ >> 6;
        const float* mod = (const float*)(p.ws + OFF_MOD);
        bf16* H = (bf16*)(p.ws + OFF_H);
        int g0, g1; wave_rows(wave, g0, g1);
        ModVec mv; int cur = -1;
        for (int g = g0; g < g1; ++g) {
            const float* xr = g < NPROMPT ? p.in[0] + (size_t)g * 1024 : p.in[1] + (size_t)(g - NPROMPT) * 1024;
            f32x4 x[4];
#pragma unroll
            for (int j = 0; j < 4; ++j) x[j] = *(const f32x4*)(xr + 4 * lane + 256 * j);
            const int mr = tok_modrow(g);
            if (mr != cur) { const float* m = mod + (size_t)(0 * 5 + mr) * 6144; load_modvec(mv, p.in[10], m + 1024, m, lane); cur = mr; }
            norm_store_row(x, mv, H + (size_t)g * 1024, lane);
        }
    }
}

template <int RT, int CT>
DEVI void gemm_tile_core(const bf16* __restrict__ RM, int r0, const bf16* __restrict__ CM, int c0, unsigned char* smem, f32x4 (&acc)[RT / 32][CT / 32], const int tid) {
    constexpr int NI = RT / 32, NJ = CT / 32, COFF = RT * 128, STAGE = (RT + CT) * 128;
    static_assert(2 * STAGE <= LDS_MAIN, "GEMM LDS stages");
    const int lane = tid & 63, wave = __builtin_amdgcn_readfirstlane(tid >> 6);
    const int wr = wave >> 1, wc = wave & 1;
#pragma unroll
    for (int i = 0; i < NI; ++i)
#pragma unroll
        for (int j = 0; j < NJ; ++j) acc[i][j] = (f32x4){0.f, 0.f, 0.f, 0.f};
    const int srow = lane >> 3, spc = lane & 7;
    const bf16* rsrc[NI]; const bf16* csrc[NJ];
#pragma unroll
    for (int i = 0; i < NI; ++i) {
        int row = 8 * (wave + 4 * i) + srow;
        rsrc[i] = RM + (size_t)(r0 + row) * 1024 + (spc ^ ((row >> 1) & 7)) * 8;
    }
#pragma unroll
    for (int i = 0; i < NJ; ++i) {
        int row = 8 * (wave + 4 * i) + srow;
        csrc[i] = CM + (size_t)(c0 + row) * 1024 + (spc ^ ((row >> 1) & 7)) * 8;
    }
    LAS unsigned char* lds = (LAS unsigned char*)smem;
#define GEMM_STAGE(ks_, buf_) do { \
        _Pragma("unroll") for (int i = 0; i < NI; ++i) \
            __builtin_amdgcn_global_load_lds((const unsigned*)(rsrc[i] + (ks_) * 64), (LAS unsigned*)(lds + (buf_) * STAGE + (wave + 4 * i) * 1024), 16, 0, 0); \
        _Pragma("unroll") for (int i = 0; i < NJ; ++i) \
            __builtin_amdgcn_global_load_lds((const unsigned*)(csrc[i] + (ks_) * 64), (LAS unsigned*)(lds + (buf_) * STAGE + COFF + (wave + 4 * i) * 1024), 16, 0, 0); \
        } while (0)
    const int g = lane >> 4, lr = lane & 15;
    GEMM_STAGE(0, 0);
    for (int ks = 0; ks < 16; ++ks) {
        asm volatile("s_waitcnt vmcnt(0)" ::: "memory");
        __syncthreads();
        const unsigned char* cur = smem + (ks & 1) * STAGE;
        bf16x8 af[2][NI], bfg[2][NJ];
#pragma unroll
        for (int kk = 0; kk < 2; ++kk) {
#pragma unroll
            for (int i = 0; i < NI; ++i) {
                int row = wr * (RT / 2) + i * 16 + lr; int ch = (kk * 4 + g) ^ ((row >> 1) & 7);
                af[kk][i] = *(const bf16x8*)(cur + row * 128 + (ch << 4));
            }
#pragma unroll
            for (int j = 0; j < NJ; ++j) {
                int row = wc * (CT / 2) + j * 16 + lr; int ch = (kk * 4 + g) ^ ((row >> 1) & 7);
                bfg[kk][j] = *(const bf16x8*)(cur + COFF + row * 128 + (ch << 4));
            }
        }
        __builtin_amdgcn_sched_barrier(0);
        if (ks + 1 < 16) GEMM_STAGE(ks + 1, (ks + 1) & 1);
        __builtin_amdgcn_sched_barrier(0);
#pragma unroll
        for (int kk = 0; kk < 2; ++kk)
#pragma unroll
            for (int i = 0; i < NI; ++i)
#pragma unroll
                for (int j = 0; j < NJ; ++j) acc[i][j] = __builtin_amdgcn_mfma_f32_16x16x32_bf16(af[kk][i], bfg[kk][j], acc[i][j], 0, 0, 0);
    }
    __syncthreads();
#undef GEMM_STAGE
}

constexpr int GT = 192;
constexpr int GMT = NTOK / GT;

DEVI void phase_zgemm(const Params& p, int l, unsigned char* smem) {
    const bf16* H = (const bf16*)(p.ws + OFF_H);
    const bf16* W = (const bf16*)(p.ws + OFF_WIN) + (size_t)l * WIN_ROWS * 1024;
    bf16* Z = (bf16*)(p.ws + OFF_Z);
    bf16* VTA = (bf16*)(p.ws + OFF_VTA); bf16* VTN = (bf16*)(p.ws + OFF_VTN);
    const int tid_ = opaque_tid(); const int lane = tid_ & 63, wave = tid_ >> 6, wr = wave >> 1, wc = wave & 1, g = lane >> 4, lr = lane & 15;
    for (int tile = blockIdx.x; tile < GMT * 28; tile += gridDim.x) {
        int mt = tile / 28, nt = tile % 28;
        if (gridDim.x == 512) {
            const int b = tile & 511, r = tile >> 9, x = b & 7, q = (b >> 3) + 64 * r;
            nt = (x & 3) + 4 * (q % 7); mt = 2 * (q / 7) + (x >> 2);
        }
        if (nt < 22) {
            f32x4 acc[4][GT / 32];
            gemm_tile_core<128, GT>(W, nt * 128, H, mt * GT, smem, acc, tid_);
            if (nt < 6 || (nt >= 9 && nt < 15)) {
                const int segbase = nt < 3 ? ZC_QA : nt < 6 ? ZC_KA : nt < 12 ? ZC_QN : ZC_KN;
                bf16* seg = (bf16*)(p.ws + (nt < 3 ? OFF_QAF : nt < 6 ? OFF_KAF : nt < 12 ? OFF_QNF : OFF_KNF));
                const int nn0 = nt * 128 + wr * 64 - segbase;
                bf16* dstb = seg + (size_t)(nn0 >> 6) * NTOK * 64;
                const bool kout = nt >= 12;
#pragma unroll
                for (int j = 0; j < GT / 32; ++j) {
                    const int tok = mt * GT + wc * (GT / 2) + j * 16 + lr;
#pragma unroll
                    for (int i = 0; i < 4; ++i) {
                        const int d = i * 16 + 4 * g;
                        const f32x4 a = acc[i][j];
                        *(uint2*)(dstb + kf_idx(tok, d)) = make_uint2(pack2(a[0], a[1]), pack2(a[2], a[3]));
                        if (kout && tok < NPROMPT) {
                            const int b = tok >> 8, t = tok & 255, hh = nn0 >> 6;
                            *(f32x4*)(p.out + O_NK + ((((size_t)b * 4 + l) * 6 + hh) * 256 + t) * 64 + d) = a;
                        }
                    }
                }
            } else {
#pragma unroll
                for (int j = 0; j < GT / 32; ++j) {
                    const int tok = mt * GT + wc * (GT / 2) + j * 16 + lr;
                    bf16* zr = Z + (size_t)tok * ZW + nt * 128 + wr * 64 + 8 * g;
#pragma unroll
                    for (int ip = 0; ip < 2; ++ip) {
                        const f32x4 a = acc[2 * ip][j], b = acc[2 * ip + 1][j];
                        *(uint4*)(zr + ip * 32) = make_uint4(pack2(a[0], a[1]), pack2(a[2], a[3]), pack2(b[0], b[1]), pack2(b[2], b[3]));
                    }
                }
            }
        } else {
            f32x4 acc[GT / 32][4];
            gemm_tile_core<GT, 128>(H, mt * GT, W, nt * 128, smem, acc, tid_);
            const bool isn = nt >= 25;
            const int hh = (nt * 128 + wc * 64 - (isn ? 3200 : 2816)) >> 6;
            bf16* vth = (isn ? VTN : VTA) + (size_t)hh * NTOK * 64;
#pragma unroll
            for (int i = 0; i < GT / 32; ++i) {
                const int tok = mt * GT + wr * (GT / 2) + i * 16 + 4 * g;
                const bool vout = isn && tok < NPROMPT;
                float* ob = p.out + O_NV + ((((size_t)(tok >> 8) * 4 + l) * 6 + hh) * 256 + (tok & 255)) * 64;
#pragma unroll
                for (int j = 0; j < 4; ++j) {
                    const int d = j * 16 + lr;
                    const f32x4 a = acc[i][j];
                    *(uint2*)(vth + vf_idx(tok, d)) = make_uint2(pack2(a[0], a[1]), pack2(a[2], a[3]));
                    if (vout) { float* o = ob + d; o[0] = a[0]; o[64] = a[1]; o[128] = a[2]; o[192] = a[3]; }
                }
            }
        }
    }
}

DEVI void phase_outgemm(const Params& p, int l, unsigned char* smem) {
    const bf16* Y = (const bf16*)(p.ws + OFF_YMIX);
    const bf16* W = (const bf16*)(p.ws + OFF_WOUT) + (size_t)l * 1024 * 1024;
    float* xw = (float*)(p.ws + OFF_XW);
    const float* mod = (const float*)(p.ws + OFF_MOD);
    const int tid_ = opaque_tid(); const int lane = tid_ & 63, wave = tid_ >> 6, wr = wave >> 1, wc = wave & 1, g = lane >> 4, lr = lane & 15;
    for (int tile = blockIdx.x; tile < GMT * 8; tile += gridDim.x) {
        const int slot = (tile % (int)gridDim.x) >> 3, xg = tile & 7, rnd = tile / (int)gridDim.x;
        int mt = (gridDim.x == 512) ? (xg + 8 * (slot >> 3)) : tile / 8, nt = (gridDim.x == 512) ? (slot & 7) : tile % 8;
        (void)rnd;
        f32x4 acc[4][GT / 32];
        gemm_tile_core<128, GT>(W, nt * 128, Y, mt * GT, smem, acc, tid_);
        const int tokw = mt * GT + wc * (GT / 2);
        const bool onerow = tok_modrow(tokw) == tok_modrow(tokw + GT / 2 - 1);
        f32x4 ggw[4];
        {
            const float* g1w = mod + (size_t)(l * 5 + tok_modrow(tokw)) * 6144 + 2048;
#pragma unroll
            for (int i = 0; i < 4; ++i) ggw[i] = *(const f32x4*)(g1w + nt * 128 + wr * 64 + i * 16 + 4 * g);
        }
#pragma unroll
        for (int j = 0; j < GT / 32; ++j) {
            int tok = mt * GT + wc * (GT / 2) + j * 16 + lr;
            const float* g1 = mod + (size_t)(l * 5 + tok_modrow(tok)) * 6144 + 2048;
#pragma unroll
            for (int i = 0; i < 4; ++i) {
                int n = nt * 128 + wr * 64 + i * 16 + 4 * g;
                f32x4 gg = ggw[i];
                if (!onerow) gg = *(const f32x4*)(g1 + n);
                float* xp = xw + (size_t)tok * 1024 + n;
                const float* xs = l == 0 ? (tok < NPROMPT ? p.in[0] + (size_t)tok * 1024 + n : p.in[1] + (size_t)(tok - NPROMPT) * 1024 + n) : xp;
                f32x4 xv = *(const f32x4*)xs;
                f32x4 a = acc[i][j];
                xv[0] += gg[0] * a[0]; xv[1] += gg[1] * a[1]; xv[2] += gg[2] * a[2]; xv[3] += gg[3] * a[3];
                *(f32x4*)xp = xv;
            }
        }
    }
}

DEVI void phase_norm2(const Params& p, int l) {
    const int tid_ = opaque_tid(); const int lane = tid_ & 63, wave = tid_ >> 6;
    const float* mod = (const float*)(p.ws + OFF_MOD);
    const float* xw = (const float*)(p.ws + OFF_XW); bf16* H = (bf16*)(p.ws + OFF_H);
    int g0, g1; wave_rows(wave, g0, g1);
    ModVec mv; int cur = -1;
    for (int g = g0; g < g1; ++g) {
        f32x4 x[4];
#pragma unroll
        for (int j = 0; j < 4; ++j) x[j] = *(const f32x4*)(xw + (size_t)g * 1024 + 4 * lane + 256 * j);
        const int mr = tok_modrow(g);
        if (mr != cur) { const float* m = mod + (size_t)(l * 5 + mr) * 6144; load_modvec(mv, p.in[11] + l * 1024, m + 4096, m + 3072, lane); cur = mr; }
        norm_store_row<true>(x, mv, H + (size_t)g * 1024, lane, p.ws + OFF_H8 + (size_t)g * 1024, (float*)(p.ws + OFF_SH8) + g);
    }
}

DEVI void phase_qgemm(const Params& p, int l, unsigned char* smem) {
    const bf16* H = (const bf16*)(p.ws + OFF_H);
    const bf16* W = (const bf16*)(p.ws + OFF_WQ) + (size_t)l * 1024 * 1024;
    bf16* QP = (bf16*)(p.ws + OFF_QP);
    const int tid_ = opaque_tid(); const int lane = tid_ & 63, wave = tid_ >> 6, wr = wave >> 1, wc = wave & 1, g = lane >> 4, lr = lane & 15;
    for (int tile = blockIdx.x; tile < GMT * 8; tile += gridDim.x) {
        const int slot = (tile % (int)gridDim.x) >> 3, xg = tile & 7, rnd = tile / (int)gridDim.x;
        int mt = (gridDim.x == 512) ? (xg + 8 * (slot >> 3)) : tile / 8, nt = (gridDim.x == 512) ? (slot & 7) : tile % 8;
        (void)rnd;
        f32x4 acc[4][GT / 32];
        gemm_tile_core<128, GT>(W, nt * 128, H, mt * GT, smem, acc, tid_);
#pragma unroll
        for (int i = 0; i < 4; ++i)
#pragma unroll
            for (int j = 0; j < GT / 32; ++j) {
                int n = nt * 128 + wr * 64 + i * 16 + 4 * g;
                int tok = mt * GT + wc * (GT / 2) + j * 16 + lr;
                f32x4 a = acc[i][j];
                *(uint2*)(QP + (size_t)tok * 1024 + n) = make_uint2(pack2(a[0], a[1]), pack2(a[2], a[3]));
            }
    }
}


DEVI void phase_gla_prep(const Params& p, int l, unsigned char* smem) {
    float* LR = (float*)smem;
    float* WA = (float*)(smem + 8448);
    float* BA = (float*)(smem + 16640);
    bf16* KS = (bf16*)(smem + 17152);
    float* CUM = (float*)(smem + 25600);
    const bf16* Z = (const bf16*)(p.ws + OFF_Z);
    const bf16* VTA = (const bf16*)(p.ws + OFF_VTA);
    bf16* QT = (bf16*)(p.ws + OFF_QT);
    float* OINTRA = (float*)(p.ws + OFF_OINTRA);
    float* UST = (float*)(p.ws + OFF_UST);
    float* DEC = (float*)(p.ws + OFF_DEC);
    const int tid = opaque_tid(), lane = tid & 63, w = tid >> 6, g = lane >> 4, lr = lane & 15;
    for (int item = blockIdx.x; item < NGITEM; item += gridDim.x) {
        const int cg = item / 6, h = item % 6, g0 = cg * 64;
        const int tloc = 16 * w + lr, tok = g0 + tloc;
        {
            int idx = tid * 8; int dir = idx >> 10, j = (idx >> 6) & 15, k = idx & 63;
            const float* src = (dir ? p.in[15] : p.in[13]) + (size_t)l * 16 * 384 + j * 384 + h * 64 + k;
            *(f32x4*)(WA + idx) = *(const f32x4*)src; *(f32x4*)(WA + idx + 4) = *(const f32x4*)(src + 4);
            if (tid < 128) { int dd = tid >> 6, kk = tid & 63; BA[tid] = (dd ? p.in[16] : p.in[14])[l * 384 + h * 64 + kk]; }
        }
        __syncthreads();
        {
            const int dir = w & 1;
            bf16x8 Af[2];
#pragma unroll
            for (int q = 0; q < 2; ++q) {
                const int t = 16 * (2 * (w >> 1) + q) + lr;
                uint4 v = make_uint4(0u, 0u, 0u, 0u);
                if (g < 2) v = *(const uint4*)(Z + (size_t)(g0 + t) * ZW + ZC_LRF + dir * 16 + 8 * g);
                Af[q] = mk_frag4(v.x, v.y, v.z, v.w);
            }
#pragma unroll
            for (int kt = 0; kt < 4; ++kt) {
                const int k = 16 * kt + lr;
                float wv[8];
#pragma unroll
                for (int jj = 0; jj < 8; ++jj) wv[jj] = g < 2 ? WA[(dir * 16 + 8 * g + jj) * 64 + k] : 0.f;
                const bf16x8 Bf = mk_frag4(pack2(wv[0], wv[1]), pack2(wv[2], wv[3]), pack2(wv[4], wv[5]), pack2(wv[6], wv[7]));
                const float bb = BA[dir * 64 + k];
#pragma unroll
                for (int q = 0; q < 2; ++q) {
                    f32x4 a = (f32x4){bb, bb, bb, bb};
                    a = __builtin_amdgcn_mfma_f32_16x16x32_bf16(Af[q], Bf, a, 0, 0, 0);
                    const int t0 = 16 * (2 * (w >> 1) + q) + 4 * g;
#pragma unroll
                    for (int e = 0; e < 4; ++e) CUM[(dir * 64 + t0 + e) * 64 + k] = log_sigmoid_f(a[e]) * (1.f / 16.f);
                }
            }
        }
        __syncthreads();
        if (tid < 128) {
            int dir = tid >> 6, k = tid & 63;
            float cv[64];
            float* cb = CUM + dir * 4096 + k;
#pragma unroll
            for (int t = 0; t < 64; ++t) cv[t] = cb[t * 64];
            float run = 0.f;
            if (dir == 0) {
#pragma unroll
                for (int t = 0; t < 64; ++t) { run += cv[t]; cv[t] = run; }
            } else {
#pragma unroll
                for (int t = 63; t >= 0; --t) { run += cv[t]; cv[t] = run; }
            }
#pragma unroll
            for (int t = 0; t < 64; ++t) cb[t * 64] = cv[t];
        }
        __syncthreads();
        uint4 qraw[2], kraw[2]; bf16x8 Vf[2];
        {
            const bf16* qaf = (const bf16*)(p.ws + OFF_QAF) + (size_t)h * NTOK * 64;
            const bf16* kaf0 = (const bf16*)(p.ws + OFF_KAF) + (size_t)h * NTOK * 64;
            const bf16* vta = VTA + (size_t)h * NTOK * 64;
#pragma unroll
            for (int kk = 0; kk < 2; ++kk) qraw[kk] = *(const uint4*)(qaf + kf_idx(tok, 32 * kk + 8 * g));
            {
                const int s = 32 * (w >> 1) + 8 * (lr >> 2) + 4 * (w & 1) + (lr & 3);
#pragma unroll
                for (int kk = 0; kk < 2; ++kk) kraw[kk] = *(const uint4*)(kaf0 + kf_idx(g0 + s, 32 * kk + 8 * g));
            }
            Vf[0] = ld_frag(vta + vf_idx(g0 + 8 * g, 16 * w + lr));
            Vf[1] = ld_frag(vta + vf_idx(g0 + 32 + 8 * g, 16 * w + lr));
        }
        __builtin_amdgcn_sched_barrier(0);
        {
            f32x4 P[4];
#pragma unroll
            for (int st = 0; st < 4; ++st) P[st] = (f32x4){0.f, 0.f, 0.f, 0.f};
#pragma unroll 1
            for (int dir = 0; dir < 2; ++dir) {
                bf16x8 Qf[2], Kfr[4][2];
#pragma unroll
                for (int kk = 0; kk < 2; ++kk) {
                    int k0 = 32 * kk + 8 * g;
                    const uint4 q = qraw[kk];
                    const float* cp = CUM + (dir * 64 + tloc) * 64 + k0;
                    f32x4 c0 = *(const f32x4*)cp, c1 = *(const f32x4*)(cp + 4);
                    float v0 = bflo(q.x) * 0.125f * __expf(c0[0]), v1 = bfhi(q.x) * 0.125f * __expf(c0[1]);
                    float v2 = bflo(q.y) * 0.125f * __expf(c0[2]), v3 = bfhi(q.y) * 0.125f * __expf(c0[3]);
                    float v4 = bflo(q.z) * 0.125f * __expf(c1[0]), v5 = bfhi(q.z) * 0.125f * __expf(c1[1]);
                    float v6 = bflo(q.w) * 0.125f * __expf(c1[2]), v7 = bfhi(q.w) * 0.125f * __expf(c1[3]);
                    uint4 o = make_uint4(pack2(v0, v1), pack2(v2, v3), pack2(v4, v5), pack2(v6, v7));
                    *(uint4*)(QT + ((size_t)dir * 6 + h) * NTOK * 64 + kf_idx(tok, k0)) = o;
                    Qf[kk] = mk_frag4(o.x, o.y, o.z, o.w);
                }
                {
                    unsigned char* ksh = smem + (dir ? 17152 : 0);
                    const int s = 32 * (w >> 1) + 8 * (lr >> 2) + 4 * (w & 1) + (lr & 3);
#pragma unroll
                    for (int kk = 0; kk < 2; ++kk) {
                        int k0 = 32 * kk + 8 * g;
                        const uint4 q = kraw[kk];
                        const float* cp = CUM + (dir * 64 + s) * 64 + k0;
                        f32x4 c0 = *(const f32x4*)cp, c1 = *(const f32x4*)(cp + 4);
                        float v0 = bflo(q.x) * __expf(-c0[0]), v1 = bfhi(q.x) * __expf(-c0[1]);
                        float v2 = bflo(q.y) * __expf(-c0[2]), v3 = bfhi(q.y) * __expf(-c0[3]);
                        float v4 = bflo(q.z) * __expf(-c1[0]), v5 = bfhi(q.z) * __expf(-c1[1]);
                        float v6 = bflo(q.w) * __expf(-c1[2]), v7 = bfhi(q.w) * __expf(-c1[3]);
                        *(uint4*)(ksh + ((w * 2 + kk) * 64 + lane) * 16) = make_uint4(pack2(v0, v1), pack2(v2, v3), pack2(v4, v5), pack2(v6, v7));
                    }
                    __syncthreads();
#pragma unroll
                    for (int st = 0; st < 4; ++st)
#pragma unroll
                        for (int kk = 0; kk < 2; ++kk) Kfr[st][kk] = *(const bf16x8*)(ksh + ((st * 2 + kk) * 64 + lane) * 16);
                }
#pragma unroll
                for (int st = 0; st < 4; ++st) {
                    f32x4 T = (f32x4){0.f, 0.f, 0.f, 0.f};
#pragma unroll
                    for (int kk = 0; kk < 2; ++kk) T = __builtin_amdgcn_mfma_f32_16x16x32_bf16(Kfr[st][kk], Qf[kk], T, 0, 0, 0);
#pragma unroll
                    for (int e = 0; e < 4; ++e) {
                        int sp = 32 * (st >> 1) + 8 * g + 4 * (st & 1) + e;
                        bool valid = dir == 0 ? (sp <= tloc) : (sp >= tloc);
                        P[st][e] += valid ? T[e] : 0.f;
                    }
                }
#pragma unroll
                for (int kt = 0; kt < 4; ++kt) {
                    const int k = 16 * kt + lr;
                    const float el = __expf(dir == 0 ? CUM[(0 * 64 + 63) * 64 + k] : CUM[(1 * 64 + 0) * 64 + k]);
                    unsigned sw[4];
#pragma unroll
                    for (int q = 0; q < 4; ++q) {
                        const int j0 = 8 * g + 2 * q - 16 * (kt & 1);
                        sw[q] = (j0 == lr ? 0x3F80u : 0u) | (j0 + 1 == lr ? 0x3F800000u : 0u);
                    }
                    const bf16x8 Sel = mk_frag4(sw[0], sw[1], sw[2], sw[3]);
                    f32x4 U = (f32x4){0.f, 0.f, 0.f, 0.f};
#pragma unroll
                    for (int G = 0; G < 2; ++G) {
                        f32x4 D0 = (f32x4){0.f, 0.f, 0.f, 0.f}, D1 = (f32x4){0.f, 0.f, 0.f, 0.f};
                        D0 = __builtin_amdgcn_mfma_f32_16x16x32_bf16(Kfr[2 * G][kt >> 1], Sel, D0, 0, 0, 0);
                        D1 = __builtin_amdgcn_mfma_f32_16x16x32_bf16(Kfr[2 * G + 1][kt >> 1], Sel, D1, 0, 0, 0);
                        const bf16x8 Kb = mk_frag4(pack2(D0[0], D0[1]), pack2(D0[2], D0[3]), pack2(D1[0], D1[1]), pack2(D1[2], D1[3]));
                        U = __builtin_amdgcn_mfma_f32_16x16x32_bf16(Vf[G], Kb, U, 0, 0, 0);
                    }
                    float* up = UST + (((size_t)item * 2 + dir) * 64 + 16 * w + 4 * g) * 64 + k;
                    up[0] = U[0] * el; up[64] = U[1] * el; up[128] = U[2] * el; up[192] = U[3] * el;
                }
            }
            bf16x8 vfr[4][2];
            {
                const bf16* vta = VTA + (size_t)h * NTOK * 64;
#pragma unroll
                for (int vt = 0; vt < 4; ++vt)
#pragma unroll
                    for (int kk = 0; kk < 2; ++kk) vfr[vt][kk] = ld_frag(vta + vf_idx(g0 + 32 * kk + 8 * g, 16 * vt + lr));
            }
            bf16x8 Pf[2];
#pragma unroll
            for (int kk = 0; kk < 2; ++kk)
                Pf[kk] = mk_frag4(pack2(P[2 * kk][0], P[2 * kk][1]), pack2(P[2 * kk][2], P[2 * kk][3]),
                                  pack2(P[2 * kk + 1][0], P[2 * kk + 1][1]), pack2(P[2 * kk + 1][2], P[2 * kk + 1][3]));
#pragma unroll
            for (int vt = 0; vt < 4; ++vt) {
                f32x4 O = (f32x4){0.f, 0.f, 0.f, 0.f};
#pragma unroll
                for (int kk = 0; kk < 2; ++kk) {
                    O = __builtin_amdgcn_mfma_f32_16x16x32_bf16(vfr[vt][kk], Pf[kk], O, 0, 0, 0);
                }
                *(f32x4*)(OINTRA + (size_t)tok * 384 + h * 64 + 16 * vt + 4 * g) = O;
            }
        }
        if (tid < 128) {
            int dir = tid >> 6, k = tid & 63;
            float last = dir == 0 ? CUM[(0 * 64 + 63) * 64 + k] : CUM[(1 * 64 + 0) * 64 + k];
            DEC[((size_t)item * 2 + dir) * 64 + k] = __expf(last);
        }
        __syncthreads();
    }
}

template <int B>
DEVI void scan_steps(const float* UST, const float* DEC, bf16* SST, int cbase, int nc, int dir, int h, int v, int k4, float (&S)[4], int ci0) {
    f32x4 U[B], d[B]; unsigned gq[B];
#pragma unroll
    for (int q = 0; q < B; ++q) {
        const int ci = ci0 + q, c = dir == 0 ? ci : nc - 1 - ci;
        gq[q] = (unsigned)(((cbase + c) * 6 + h) * 2 + dir);
        U[q] = *(const f32x4*)(UST + ((size_t)gq[q] * 64 + v) * 64 + k4);
        d[q] = *(const f32x4*)(DEC + (size_t)gq[q] * 64 + k4);
    }
#pragma unroll
    for (int q = 0; q < B; ++q) {
        *(uint2*)(SST + (size_t)gq[q] * 4096 + kf_idx(v, k4)) = make_uint2(pack2(S[0], S[1]), pack2(S[2], S[3]));
#pragma unroll
        for (int i = 0; i < 4; ++i) S[i] = d[q][i] * S[i] + U[q][i];
    }
}
DEVI void phase_scan(const Params& p, int l) {
    const float* UST = (const float*)(p.ws + OFF_UST);
    const float* DEC = (const float*)(p.ws + OFF_DEC);
    bf16* SST = (bf16*)(p.ws + OFF_SST);
    const int tid = opaque_tid();
    for (int item = blockIdx.x; item < 960; item += gridDim.x) {
        int part = item & 3, dir = (item >> 2) & 1, sh = item >> 3, h = sh % 6, seq = sh / 6;
        int cbase = seq < 16 ? seq * 4 : 64 + (seq - 16) * 32, nc = seq < 16 ? 4 : 32;
        int e4 = part * 256 + tid, v = e4 >> 4, k4 = (e4 & 15) * 4;
        float S[4] = {0.f, 0.f, 0.f, 0.f};
        if (seq >= 16) {
            const float* st = (dir ? p.in[5] : p.in[4]) + ((((size_t)(seq - 16) * 4 + l) * 6 + h) * 64) * 64;
#pragma unroll
            for (int i = 0; i < 4; ++i) S[i] = st[(k4 + i) * 64 + v];
        }
        if (nc == 4) scan_steps<4>(UST, DEC, SST, cbase, nc, dir, h, v, k4, S, 0);
        else for (int ci0 = 0; ci0 < nc; ci0 += 8) scan_steps<8>(UST, DEC, SST, cbase, nc, dir, h, v, k4, S, ci0);
        if (seq < 16) {
            float* o = p.out + (dir ? O_GB : O_GF) + ((((size_t)seq * 4 + l) * 6 + h) * 64) * 64;
#pragma unroll
            for (int i = 0; i < 4; ++i) o[(k4 + i) * 64 + v] = S[i];
        }
    }
}

struct AttnFr { bf16x8 k[4][2]; bf16x8 v[4][2]; };
struct AttnDesc { const bf16* kbase; const bf16* vbase; int kg[2]; int dri[2]; int kc0[2]; int win; };

DEVI AttnDesc attn_make_desc(int c, bool samp, const bf16* kb_ctx, const bf16* vb_ctx, const bf16* kb_tok, const bf16* vb_tok,
                             int seqbase, int rs, int kcw, int r) {
    AttnDesc d;
    const bool ctx = samp && c < 4;
    const bool win = samp && c >= 4;
    d.kbase = ctx ? kb_ctx : kb_tok;
    d.vbase = ctx ? vb_ctx : vb_tok;
    d.win = win ? 1 : 0;
    const int kr0 = rs + 2 * (c - 4), kr1 = kr0 + 1;
    const int base = ctx ? 0 : seqbase;
    d.kg[0] = win ? seqbase + kr0 * 64 + kcw : base + 64 * c;
    d.kg[1] = win ? seqbase + kr1 * 64 + kcw : base + 64 * c + 32;
    d.dri[0] = win ? kr0 - r + 7 : 0; d.dri[1] = win ? kr1 - r + 7 : 0;
    d.kc0[0] = d.kc0[1] = win ? kcw : 0;
    return d;
}
DEVI void attn_load(const AttnDesc& d, int g, int lr, AttnFr& f) {
    const int klane = (lr >> 2) * 512 + g * 32 + (lr & 3) * 8;
    const int vlane = g * 512 + lr * 8;
#pragma unroll
    for (int grp = 0; grp < 2; ++grp) {
        const bf16* kp = d.kbase + (size_t)d.kg[grp] * 64 + klane;
        const bf16* vp = d.vbase + (size_t)d.kg[grp] * 64 + vlane;
#pragma unroll
        for (int T = 0; T < 2; ++T) {
            f.k[2 * grp + T][0] = ld_frag(kp + T * 128);
            f.k[2 * grp + T][1] = ld_frag(kp + T * 128 + 256);
        }
#pragma unroll
        for (int vt = 0; vt < 4; ++vt) f.v[vt][grp] = ld_frag(vp + vt * 128);
    }
}

template <bool WIN>
DEVI void attn_compute(f32x4 (&O)[4], float& m, float& lsum, const bf16x8 (&Qf)[2], const AttnFr& f, const AttnDesc& d,
                       const float* rpbh, int qc, int g, int lr) {
    f32x4 S[4];
    float cm = -1e30f;
    const int cs = min(max(qc - 8, 0), 48);
#pragma unroll
    for (int ti = 0; ti < 4; ++ti) {
        f32x4 T = (f32x4){0.f, 0.f, 0.f, 0.f};
        T = __builtin_amdgcn_mfma_f32_16x16x32_bf16(f.k[ti][0], Qf[0], T, 0, 0, 0);
        T = __builtin_amdgcn_mfma_f32_16x16x32_bf16(f.k[ti][1], Qf[1], T, 0, 0, 0);
#pragma unroll
        for (int e = 0; e < 4; ++e) {
            float s = T[e] * 0.125f;
            if (WIN) {
                int kc = d.kc0[ti >> 1] + 8 * g + 4 * (ti & 1) + e;
                bool valid = kc >= cs && kc < cs + 16;
                int dc = min(max(kc - qc, -15), 15) + 15;
                float bias = rpbh[d.dri[ti >> 1] * 31 + dc];
                s = valid ? s + bias : -1e30f;
            }
            T[e] = s; cm = fmaxf(cm, s);
        }
        S[ti] = T;
    }
    {
        auto s16 = __builtin_amdgcn_permlane16_swap(__float_as_uint(cm), __float_as_uint(cm), false, false);
        cm = fmaxf(__uint_as_float((unsigned)s16[0]), __uint_as_float((unsigned)s16[1]));
        auto s32 = __builtin_amdgcn_permlane32_swap(__float_as_uint(cm), __float_as_uint(cm), false, false);
        cm = fmaxf(__uint_as_float((unsigned)s32[0]), __uint_as_float((unsigned)s32[1]));
    }
    float mn = fmaxf(m, cm);
    if (__builtin_amdgcn_ballot_w64(cm > m) != 0ull) {
        const float alpha = __expf(m - mn);
        m = mn;
#pragma unroll
        for (int vt = 0; vt < 4; ++vt) { O[vt][0] *= alpha; O[vt][1] *= alpha; O[vt][2] *= alpha; O[vt][3] *= alpha; }
        lsum *= alpha;
    }
    float ps = 0.f;
#pragma unroll
    for (int ti = 0; ti < 4; ++ti)
#pragma unroll
        for (int e = 0; e < 4; ++e) { float s = S[ti][e]; float pv = (!WIN || s > -1e29f) ? __expf(s - mn) : 0.f; S[ti][e] = pv; ps += pv; }
    lsum += ps;
    bf16x8 Pf[2];
#pragma unroll
    for (int kk = 0; kk < 2; ++kk)
        Pf[kk] = mk_frag4(pack2(S[2 * kk][0], S[2 * kk][1]), pack2(S[2 * kk][2], S[2 * kk][3]),
                          pack2(S[2 * kk + 1][0], S[2 * kk + 1][1]), pack2(S[2 * kk + 1][2], S[2 * kk + 1][3]));
#pragma unroll
    for (int vt = 0; vt < 4; ++vt)
#pragma unroll
        for (int kk = 0; kk < 2; ++kk)
            O[vt] = __builtin_amdgcn_mfma_f32_16x16x32_bf16(f.v[vt][kk], Pf[kk], O[vt], 0, 0, 0);
}

DEVI void phase_attn(const Params& p, int l, unsigned char* smem, int rep = 0) {
    float* RPB = (float*)smem;
    volatile int* CLAIM = (volatile int*)(smem + 4096);
    const bf16* Z = (const bf16*)(p.ws + OFF_Z);
    const bf16* VTN = (const bf16*)(p.ws + OFF_VTN);
    const bf16* CK = (const bf16*)(p.ws + OFF_CK);
    const bf16* CVT = (const bf16*)(p.ws + OFF_CVT);
    bf16* YMIX = (bf16*)(p.ws + OFF_YMIX);
    const int tid = opaque_tid(), lane = tid & 63, w = tid >> 6, g = lane >> 4, lr = lane & 15;
    unsigned* qcnt = (unsigned*)(p.ws + OFF_CTL + 16384) + (64 + l + 4 * rep) * 16;
    for (;;) {
        __syncthreads();
        if (tid == 0) CLAIM[0] = (int)xb_add(qcnt, 1u);
        __syncthreads();
        const int item = CLAIM[0];
        if (item >= 768 + 384) break;
        f32x4 O[4];
#pragma unroll
        for (int vt = 0; vt < 4; ++vt) O[vt] = (f32x4){0.f, 0.f, 0.f, 0.f};
        float m = -1e30f, lsum = 0.f;
        int qtok, h, nchunk, b, r = 0, seqbase, qc = 0, rs = 0, kcw = 0;
        if (item < 768) {
            b = item / 192; int r2 = item % 192; h = r2 / 32; r = r2 % 32;
            for (int i = tid; i < 465; i += 256) RPB[i] = p.in[20][((size_t)(l * 6 + h) * 15) * 31 + i];
            __syncthreads();
            seqbase = NPROMPT + b * 2048; qc = 16 * w + lr; qtok = seqbase + r * 64 + qc; nchunk = 8;
            rs = min(max(r - 4, 0), 24); kcw = min(max(16 * w - 8, 0), 32);
        } else {
            int it = item - 768; b = it / 24; int r2 = it % 24; h = r2 / 4; int qb = r2 % 4;
            seqbase = b * 256; qtok = seqbase + qb * 64 + 16 * w + lr; nchunk = 4;
        }
        const bool samp = item < 768;
        bf16x8 Qf[2];
        { const bf16* qb = (const bf16*)(p.ws + OFF_QNF) + (size_t)h * NTOK * 64; Qf[0] = ld_frag(qb + kf_idx(qtok, 8 * g)); Qf[1] = ld_frag(qb + kf_idx(qtok, 8 * g + 32)); }
        const bf16* kb_ctx = CK + (((size_t)b * 4 + l) * 6 + h) * 256 * 64;
        const bf16* vb_ctx = CVT + (((size_t)b * 4 + l) * 6 + h) * 64 * 256;
        const bf16* kb_tok = (const bf16*)(p.ws + OFF_KNF) + (size_t)h * NTOK * 64;
        const bf16* vb_tok = VTN + (size_t)h * NTOK * 64;
        AttnFr fa, fb; { const AttnDesc d0 = attn_make_desc(0, samp, kb_ctx, vb_ctx, kb_tok, vb_tok, seqbase, rs, kcw, r); attn_load(d0, g, lr, fa); }
#pragma unroll 1
        for (int c = 0; c < nchunk; c += 2) {
            { const AttnDesc dn = attn_make_desc(c + 1, samp, kb_ctx, vb_ctx, kb_tok, vb_tok, seqbase, rs, kcw, r); attn_load(dn, g, lr, fb); }
            __builtin_amdgcn_sched_barrier(0);
            { const AttnDesc dc = attn_make_desc(c, samp, kb_ctx, vb_ctx, kb_tok, vb_tok, seqbase, rs, kcw, r);
              if (dc.win) attn_compute<true>(O, m, lsum, Qf, fa, dc, RPB, qc, g, lr); else attn_compute<false>(O, m, lsum, Qf, fa, dc, RPB, qc, g, lr); }
            __builtin_amdgcn_sched_barrier(0);
            { const AttnDesc dn = attn_make_desc(min(c + 2, nchunk - 1), samp, kb_ctx, vb_ctx, kb_tok, vb_tok, seqbase, rs, kcw, r); attn_load(dn, g, lr, fa); }
            __builtin_amdgcn_sched_barrier(0);
            { const AttnDesc dc = attn_make_desc(c + 1, samp, kb_ctx, vb_ctx, kb_tok, vb_tok, seqbase, rs, kcw, r);
              if (dc.win) attn_compute<true>(O, m, lsum, Qf, fb, dc, RPB, qc, g, lr); else attn_compute<false>(O, m, lsum, Qf, fb, dc, RPB, qc, g, lr); }
        }
        lsum += __shfl_xor(lsum, 16); lsum += __shfl_xor(lsum, 32);
        float inv = 1.f / lsum;
#pragma unroll
        for (int vt = 0; vt < 4; ++vt) {
            f32x4 o = O[vt];
            *(uint2*)(YMIX + (size_t)qtok * 1024 + 640 + h * 64 + 16 * vt + 4 * g) = make_uint2(pack2(o[0] * inv, o[1] * inv), pack2(o[2] * inv, o[3] * inv));
        }
    }
}

DEVI void phase_gla_out(const Params& p, int l) {
    const bf16* Z = (const bf16*)(p.ws + OFF_Z);
    const bf16* QT = (const bf16*)(p.ws + OFF_QT);
    const bf16* SST = (const bf16*)(p.ws + OFF_SST);
    const float* OINTRA = (const float*)(p.ws + OFF_OINTRA);
    bf16* YMIX = (bf16*)(p.ws + OFF_YMIX);
    const int tid = opaque_tid(), lane = tid & 63, w = tid >> 6, g = lane >> 4, lr = lane & 15;
    for (int item = blockIdx.x; item < NGITEM; item += gridDim.x) {
        const int cg = item / 6, h = item % 6, g0 = cg * 64;
        const int tok = g0 + 16 * w + lr;
        f32x4 O[4];
#pragma unroll
        for (int vt = 0; vt < 4; ++vt) O[vt] = *(const f32x4*)(OINTRA + (size_t)tok * 384 + h * 64 + 16 * vt + 4 * g);
        f32x4 wvv[4]; uint2 gzv[4];
#pragma unroll
        for (int vt = 0; vt < 4; ++vt) {
            const int n = h * 64 + 16 * vt + 4 * g;
            wvv[vt] = *(const f32x4*)(p.in[17] + l * 384 + n);
            gzv[vt] = *(const uint2*)(Z + (size_t)tok * ZW + ZC_GA + n);
        }
        bf16x8 Qfa[2][2], Sfa[2][2][4];
#pragma unroll
        for (int dir = 0; dir < 2; ++dir)
#pragma unroll
            for (int kk = 0; kk < 2; ++kk) {
                Qfa[dir][kk] = ld_frag(QT + ((size_t)dir * 6 + h) * NTOK * 64 + kf_idx(tok, 32 * kk + 8 * g));
#pragma unroll
                for (int vt = 0; vt < 4; ++vt) Sfa[dir][kk][vt] = ld_frag(SST + ((size_t)item * 2 + dir) * 4096 + kf_idx(16 * vt + lr, 32 * kk + 8 * g));
            }
        __builtin_amdgcn_sched_barrier(0);
#pragma unroll
        for (int dir = 0; dir < 2; ++dir)
#pragma unroll
            for (int kk = 0; kk < 2; ++kk) {
#pragma unroll
                for (int vt = 0; vt < 4; ++vt) O[vt] = __builtin_amdgcn_mfma_f32_16x16x32_bf16(Sfa[dir][kk][vt], Qfa[dir][kk], O[vt], 0, 0, 0);
            }
        float ss = 0.f;
#pragma unroll
        for (int vt = 0; vt < 4; ++vt) ss += O[vt][0] * O[vt][0] + O[vt][1] * O[vt][1] + O[vt][2] * O[vt][2] + O[vt][3] * O[vt][3];
        ss += __shfl_xor(ss, 16); ss += __shfl_xor(ss, 32);
        float rstd = rsqrtf(ss * (1.f / 64.f) + EPS);
#pragma unroll
        for (int vt = 0; vt < 4; ++vt) {
            int n = h * 64 + 16 * vt + 4 * g;
            const f32x4 wv = wvv[vt]; const uint2 gz = gzv[vt];
            float y0 = O[vt][0] * rstd * wv[0] * silu_f(bflo(gz.x));
            float y1 = O[vt][1] * rstd * wv[1] * silu_f(bfhi(gz.x));
            float y2 = O[vt][2] * rstd * wv[2] * silu_f(bflo(gz.y));
            float y3 = O[vt][3] * rstd * wv[3] * silu_f(bfhi(gz.y));
            *(uint2*)(YMIX + (size_t)tok * 1024 + n) = make_uint2(pack2(y0, y1), pack2(y2, y3));
        }
    }
    {
        const float* cw = p.in[18] + l * 3 * 256; const float* cbias = p.in[19] + l * 256;
        size_t gt = (size_t)blockIdx.x * 256 + tid, gs = (size_t)gridDim.x * 256;
        for (size_t idx = gt; idx < (size_t)NTOK * 32; idx += gs) {
            int tok = (int)(idx >> 5), c8 = (int)(idx & 31) * 8;
            int pos = tok < NPROMPT ? (tok & 255) : ((tok - NPROMPT) & 2047);
            int T = tok < NPROMPT ? 256 : 2048;
            const bf16* zr = Z + (size_t)tok * ZW;
            uint4 chc = *(const uint4*)(zr + ZC_CH + c8), ccc = *(const uint4*)(zr + ZC_CC + c8), cbb = *(const uint4*)(zr + ZC_CB + c8);
            uint4 chp = make_uint4(0, 0, 0, 0), ccp = chp, chn = chp, ccn = chp;
            if (pos > 0) { chp = *(const uint4*)(zr - ZW + ZC_CH + c8); ccp = *(const uint4*)(zr - ZW + ZC_CC + c8); }
            if (pos < T - 1) { chn = *(const uint4*)(zr + ZW + ZC_CH + c8); ccn = *(const uint4*)(zr + ZW + ZC_CC + c8); }
            const unsigned* a_chc = (const unsigned*)&chc; const unsigned* a_ccc = (const unsigned*)&ccc; const unsigned* a_cbb = (const unsigned*)&cbb;
            const unsigned* a_chp = (const unsigned*)&chp; const unsigned* a_ccp = (const unsigned*)&ccp;
            const unsigned* a_chn = (const unsigned*)&chn; const unsigned* a_ccn = (const unsigned*)&ccn;
            unsigned o[4];
#pragma unroll
            for (int q = 0; q < 4; ++q) {
                float r[2];
#pragma unroll
                for (int hf = 0; hf < 2; ++hf) {
                    int c = c8 + 2 * q + hf;
                    float up = hf ? bfhi(a_chp[q]) * bfhi(a_ccp[q]) : bflo(a_chp[q]) * bflo(a_ccp[q]);
                    float uc = hf ? bfhi(a_chc[q]) * bfhi(a_ccc[q]) : bflo(a_chc[q]) * bflo(a_ccc[q]);
                    float un = hf ? bfhi(a_chn[q]) * bfhi(a_ccn[q]) : bflo(a_chn[q]) * bflo(a_ccn[q]);
                    float bgate = hf ? bfhi(a_cbb[q]) : bflo(a_cbb[q]);
                    r[hf] = bgate * (cw[c] * up + cw[256 + c] * uc + cw[512 + c] * un + cbias[c]);
                }
                o[q] = pack2(r[0], r[1]);
            }
            *(uint4*)(YMIX + (size_t)tok * 1024 + 384 + c8) = make_uint4(o[0], o[1], o[2], o[3]);
        }
    }
}

typedef __attribute__((ext_vector_type(2))) __bf16 bf2v;
typedef __attribute__((ext_vector_type(2))) float f32x2;
DEVI float dot2bf(unsigned a, unsigned b, float c) {
    return __builtin_amdgcn_fdot2_f32_bf16(__builtin_bit_cast(bf2v, a), __builtin_bit_cast(bf2v, b), c, false);
}

#define FOR64(body) _Pragma("unroll") for (int rt = 0; rt < 4; ++rt) { _Pragma("unroll") for (int rg = 0; rg < 16; ++rg) { const float v = acc[rt][rg]; body } }

DEVI unsigned pk_sub_sat_u16(unsigned a, unsigned b) { unsigned d; asm("v_pk_sub_u16 %0, %1, %2 clamp" : "=v"(d) : "v"(a), "v"(b)); return d; }
DEVI unsigned pk_min_u16(unsigned a, unsigned b) { unsigned d; asm("v_pk_min_u16 %0, %1, %2" : "=v"(d) : "v"(a), "v"(b)); return d; }
DEVI unsigned pk_add_u16(unsigned a, unsigned b) { unsigned d; asm("v_pk_add_u16 %0, %1, %2" : "=v"(d) : "v"(a), "v"(b)); return d; }
template <int N> DEVI unsigned pk_count_gt(const unsigned (&kp)[N], unsigned t) {
    const unsigned t2 = t * 0x00010001u;
    unsigned c0 = 0u, c1 = 0u;
#pragma unroll
    for (int j = 0; j < N; j += 2) {
        c0 = pk_add_u16(c0, pk_min_u16(pk_sub_sat_u16(kp[j], t2), 0x00010001u));
        c1 = pk_add_u16(c1, pk_min_u16(pk_sub_sat_u16(kp[j + 1], t2), 0x00010001u));
    }
    const unsigned c = pk_add_u16(c0, c1);
    return (c & 0xffffu) + (c >> 16);
}
template <int N> DEVI void pk_select16(const unsigned (&kp)[N], unsigned& T, unsigned& cgt_own, unsigned& cge_own) {
    unsigned lo = 0u, hi = 65536u;
#pragma unroll 1
    for (int it = 0; it < 16; ++it) {
        const unsigned mid = (lo + hi) >> 1;
        unsigned c = pk_count_gt<N>(kp, mid - 1u);
        c += __shfl_xor(c, 32);
        const bool ge = c >= 16u;
        lo = ge ? mid : lo; hi = ge ? hi : mid;
    }
    T = lo;
    cgt_own = pk_count_gt<N>(kp, T);
    cge_own = T == 0u ? (unsigned)(2 * N) : pk_count_gt<N>(kp, T - 1u);
}
DEVI unsigned quant16(float v, float mn, float scale) { return (unsigned)__builtin_fminf(__builtin_fmaxf((v - mn) * scale + 0.5f, 0.f), 65535.f); }

DEVI void phase_peer_score(const Params& p, int l, unsigned char* smem) {
    const bf16* QP = (const bf16*)(p.ws + OFF_QP);
    int* PIDX = (int*)(p.ws + OFF_PIDX);
    float* PG = (float*)(p.ws + OFF_PG);
    f32x2* PGS = (f32x2*)(p.ws + OFF_PGS);
    const f32x2* SUVl = (const f32x2*)(p.ws + OFF_SU) + (size_t)l * 16384;
    const int tid = opaque_tid(), lane = tid & 63, w = tid >> 6, tl = lane & 31, hh = lane >> 5;
    float* LV = (float*)(smem + w * 12288);
    int* LI = (int*)(smem + w * 12288 + 4096);
    float* FV = (float*)(smem + w * 12288 + 8192);
    int* FI = (int*)(smem + w * 12288 + 10240);
    {
        f32x4* az = (f32x4*)(p.ws + OFF_ACT);
        float zz = 0.f; asm volatile("" : "+v"(zz));
        for (size_t i = (size_t)blockIdx.x * 256 + tid; i < (size_t)NTOK * 128 / 4; i += (size_t)gridDim.x * 256) az[i] = (f32x4){zz, zz, zz, zz};
    }
    for (int item = blockIdx.x; item < 768; item += gridDim.x) {
        const int tt = item >> 1, h = (item & 1) * 4 + w;
        const int tok = tt * 32 + tl;
        __builtin_amdgcn_wave_barrier();
#pragma unroll 1
        for (int side = 0; side < 2; ++side) {
            bf16x8 qfs[4], kfs[4][4];
            {
                const bf16* kb = (const bf16*)(p.ws + (side ? OFF_K2 : OFF_K1)) + ((size_t)(l * 8 + h) * 128) * 64;
#pragma unroll
                for (int ks = 0; ks < 4; ++ks) {
                    qfs[ks] = ld_frag(QP + (size_t)tok * 1024 + h * 128 + side * 64 + 16 * ks + 8 * hh);
#pragma unroll
                    for (int rt = 0; rt < 4; ++rt) kfs[ks][rt] = ld_frag(kb + (size_t)(32 * rt + tl) * 64 + 16 * ks + 8 * hh);
                }
            }
            __builtin_amdgcn_sched_barrier(0);
            f32x16 acc[4];
#pragma unroll
            for (int rt = 0; rt < 4; ++rt)
#pragma unroll
                for (int rg = 0; rg < 16; ++rg) acc[rt][rg] = 0.f;
#pragma unroll
            for (int ks = 0; ks < 4; ++ks)
#pragma unroll
                for (int rt = 0; rt < 4; ++rt) acc[rt] = __builtin_amdgcn_mfma_f32_32x32x16_bf16(kfs[ks][rt], qfs[ks], acc[rt], 0, 0, 0);
            float mx = -3e38f, mn = 3e38f;
            FOR64(mx = fmaxf(mx, v); mn = fminf(mn, v);)
            mx = fmaxf(mx, __shfl_xor(mx, 32)); mn = fminf(mn, __shfl_xor(mn, 32));
            const float scale = mx > mn ? 16777215.f * __builtin_amdgcn_rcpf(mx - mn) : 0.f, koff = -mn * scale;
            const unsigned lowc = 127u - 4u * hh;
            unsigned K[64];
#pragma unroll
            for (int rt = 0; rt < 4; ++rt)
#pragma unroll
                for (int rg = 0; rg < 16; ++rg) {
                    const unsigned q = (unsigned)__builtin_fmaf(acc[rt][rg], scale, koff);
                    K[rt * 16 + rg] = (q << 7) | (lowc - (unsigned)(32 * rt + (rg & 3) + 8 * (rg >> 2)));
                }
#define CEU(a, b) { const unsigned h_ = max(K[a], K[b]), l_ = min(K[a], K[b]); K[a] = h_; K[b] = l_; }
#define SORT16(o) CEU(o+0,o+1) CEU(o+2,o+3) CEU(o+4,o+5) CEU(o+6,o+7) CEU(o+8,o+9) CEU(o+10,o+11) CEU(o+12,o+13) CEU(o+14,o+15) CEU(o+0,o+2) CEU(o+1,o+3) CEU(o+4,o+6) CEU(o+5,o+7) CEU(o+8,o+10) CEU(o+9,o+11) CEU(o+12,o+14) CEU(o+13,o+15) CEU(o+1,o+2) CEU(o+5,o+6) CEU(o+9,o+10) CEU(o+13,o+14) CEU(o+0,o+4) CEU(o+1,o+5) CEU(o+2,o+6) CEU(o+3,o+7) CEU(o+8,o+12) CEU(o+9,o+13) CEU(o+10,o+14) CEU(o+11,o+15) CEU(o+2,o+4) CEU(o+3,o+5) CEU(o+10,o+12) CEU(o+11,o+13) CEU(o+1,o+2) CEU(o+3,o+4) CEU(o+5,o+6) CEU(o+9,o+10) CEU(o+11,o+12) CEU(o+13,o+14) CEU(o+0,o+8) CEU(o+1,o+9) CEU(o+2,o+10) CEU(o+3,o+11) CEU(o+4,o+12) CEU(o+5,o+13) CEU(o+6,o+14) CEU(o+7,o+15) CEU(o+4,o+8) CEU(o+5,o+9) CEU(o+6,o+10) CEU(o+7,o+11) CEU(o+2,o+4) CEU(o+3,o+5) CEU(o+6,o+8) CEU(o+7,o+9) CEU(o+10,o+12) CEU(o+11,o+13) CEU(o+1,o+2) CEU(o+3,o+4) CEU(o+5,o+6) CEU(o+7,o+8) CEU(o+9,o+10) CEU(o+11,o+12) CEU(o+13,o+14)
#define BITONIC16(x) CEU(x+0,x+8) CEU(x+1,x+9) CEU(x+2,x+10) CEU(x+3,x+11) CEU(x+4,x+12) CEU(x+5,x+13) CEU(x+6,x+14) CEU(x+7,x+15) CEU(x+0,x+4) CEU(x+1,x+5) CEU(x+2,x+6) CEU(x+3,x+7) CEU(x+8,x+12) CEU(x+9,x+13) CEU(x+10,x+14) CEU(x+11,x+15) CEU(x+0,x+2) CEU(x+1,x+3) CEU(x+4,x+6) CEU(x+5,x+7) CEU(x+8,x+10) CEU(x+9,x+11) CEU(x+12,x+14) CEU(x+13,x+15) CEU(x+0,x+1) CEU(x+2,x+3) CEU(x+4,x+5) CEU(x+6,x+7) CEU(x+8,x+9) CEU(x+10,x+11) CEU(x+12,x+13) CEU(x+14,x+15)
#define MERGE16(x, y) { _Pragma("unroll") for (int i_ = 0; i_ < 16; ++i_) K[x + i_] = max(K[x + i_], K[y + 15 - i_]); BITONIC16(x) }
            SORT16(0) SORT16(16) SORT16(32) SORT16(48)
            MERGE16(0, 16) MERGE16(32, 48) MERGE16(0, 32)
            {
                unsigned P[16];
#pragma unroll
                for (int i = 0; i < 16; ++i) {
                    auto sw = __builtin_amdgcn_permlane32_swap(K[15 - i], K[15 - i], false, false);
                    P[i] = hh ? (unsigned)sw[0] : (unsigned)sw[1];
                }
#pragma unroll
                for (int i = 0; i < 16; ++i) K[i] = max(K[i], P[i]);
                BITONIC16(0)
            }
#undef MERGE16
#undef BITONIC16
#undef SORT16
#undef CEU
            {
                const float inv = mx > mn ? (mx - mn) * (1.f / 16777215.f) : 0.f;
                unsigned* dst = (unsigned*)(hh ? (void*)(LI + (side * 32 + tl) * 16) : (void*)(LV + (side * 32 + tl) * 16));
#pragma unroll
                for (int i = 0; i < 16; i += 4) {
                    unsigned o4[4];
#pragma unroll
                    for (int k = 0; k < 4; ++k) {
                        const unsigned key = K[i + k];
                        const float val = __builtin_fmaf((float)(key >> 7), inv, mn);
                        o4[k] = hh ? (127u - (key & 127u)) : __float_as_uint(val);
                    }
                    *(uint4*)(dst + i) = make_uint4(o4[0], o4[1], o4[2], o4[3]);
                }
            }
        }
        __builtin_amdgcn_wave_barrier();
        {
            float v1[16], v2[16];
#pragma unroll
            for (int a = 0; a < 16; ++a) v1[a] = LV[(0 * 32 + tl) * 16 + a];
#pragma unroll
            for (int b = 0; b < 16; ++b) v2[b] = LV[(1 * 32 + tl) * 16 + b];
            const float mx = v1[0] + v2[0];
            float mn = v1[15] + v2[0];
            mn = fminf(mn, v1[0] + v2[15]); mn = fminf(mn, v1[7] + v2[1]); mn = fminf(mn, v1[1] + v2[7]); mn = fminf(mn, v1[4] + v2[2]);
            mn = fminf(mn, v1[2] + v2[4]); mn = fminf(mn, v1[3] + v2[3]);
            const float scale = mx > mn ? 8388607.f * __builtin_amdgcn_rcpf(mx - mn) : 0.f, koff = -mn * scale;
            unsigned K[32];
#define CAND(i, a0, b0, a1, b1) { const float cs_ = hh ? v1[a1] + v2[b1] : v1[a0] + v2[b0]; const unsigned q_ = (unsigned)__builtin_fmaf(cs_, scale, koff); \
                                  K[i] = (q_ << 8) | (hh ? (unsigned)(255 - (16 * a1 + b1)) : (unsigned)(255 - (16 * a0 + b0))); }
            CAND(0, 0, 0, 0, 1)
            CAND(1, 0, 2, 0, 3)
            CAND(2, 0, 4, 0, 5)
            CAND(3, 0, 6, 0, 7)
            CAND(4, 0, 8, 0, 9)
            CAND(5, 0, 10, 0, 11)
            CAND(6, 0, 12, 0, 13)
            CAND(7, 0, 14, 0, 15)
            CAND(8, 1, 0, 1, 1)
            CAND(9, 1, 2, 1, 3)
            CAND(10, 1, 4, 1, 5)
            CAND(11, 1, 6, 1, 7)
            CAND(12, 2, 0, 2, 1)
            CAND(13, 2, 2, 2, 3)
            CAND(14, 2, 4, 3, 0)
            CAND(15, 3, 1, 3, 2)
            CAND(16, 3, 3, 4, 0)
            CAND(17, 4, 1, 4, 2)
            CAND(18, 5, 0, 5, 1)
            CAND(19, 6, 0, 6, 1)
            CAND(20, 7, 0, 7, 1)
            CAND(21, 8, 0, 9, 0)
            CAND(22, 10, 0, 11, 0)
            CAND(23, 12, 0, 13, 0)
            CAND(24, 14, 0, 15, 0)
#undef CAND
#define CEU(a, b) { const unsigned h_ = max(K[a], K[b]), l_ = min(K[a], K[b]); K[a] = h_; K[b] = l_; }
            CEU(0,1) CEU(2,3) CEU(4,5) CEU(6,7) CEU(8,9) CEU(10,11) CEU(12,13) CEU(14,15) CEU(0,2) CEU(1,3) CEU(4,6) CEU(5,7) CEU(8,10) CEU(9,11) CEU(12,14) CEU(13,15) CEU(1,2) CEU(5,6) CEU(9,10) CEU(13,14) CEU(0,4) CEU(1,5) CEU(2,6) CEU(3,7) CEU(8,12) CEU(9,13) CEU(10,14) CEU(11,15) CEU(2,4) CEU(3,5) CEU(10,12) CEU(11,13) CEU(1,2) CEU(3,4) CEU(5,6) CEU(9,10) CEU(11,12) CEU(13,14) CEU(0,8) CEU(1,9) CEU(2,10) CEU(3,11) CEU(4,12) CEU(5,13) CEU(6,14) CEU(7,15) CEU(4,8) CEU(5,9) CEU(6,10) CEU(7,11) CEU(2,4) CEU(3,5) CEU(6,8) CEU(7,9) CEU(10,12) CEU(11,13) CEU(1,2) CEU(3,4) CEU(5,6) CEU(7,8) CEU(9,10) CEU(11,12) CEU(13,14)
#define CEV(a, b) CEU(16 + a, 16 + b)
            CEV(0,1) CEV(2,3) CEV(4,5) CEV(6,7) CEV(0,2) CEV(1,3) CEV(4,6) CEV(5,7) CEV(1,2) CEV(5,6) CEV(0,4) CEV(1,5) CEV(2,6) CEV(3,7) CEV(2,4) CEV(3,5) CEV(1,2) CEV(3,4) CEV(5,6) CEV(0,8) CEV(4,8) CEV(2,4) CEV(3,5) CEV(6,8) CEV(1,2) CEV(3,4) CEV(5,6) CEV(7,8)
#undef CEV
#define BITONIC16 CEU(0,8) CEU(1,9) CEU(2,10) CEU(3,11) CEU(4,12) CEU(5,13) CEU(6,14) CEU(7,15) CEU(0,4) CEU(1,5) CEU(2,6) CEU(3,7) CEU(8,12) CEU(9,13) CEU(10,14) CEU(11,15) CEU(0,2) CEU(1,3) CEU(4,6) CEU(5,7) CEU(8,10) CEU(9,11) CEU(12,14) CEU(13,15) CEU(0,1) CEU(2,3) CEU(4,5) CEU(6,7) CEU(8,9) CEU(10,11) CEU(12,13) CEU(14,15)
#pragma unroll
            for (int i = 7; i < 16; ++i) K[i] = max(K[i], K[16 + 15 - i]);
            BITONIC16
            {
                unsigned P[16];
#pragma unroll
                for (int i = 0; i < 16; ++i) {
                    auto sw = __builtin_amdgcn_permlane32_swap(K[15 - i], K[15 - i], false, false);
                    P[i] = hh ? (unsigned)sw[0] : (unsigned)sw[1];
                }
#pragma unroll
                for (int i = 0; i < 16; ++i) K[i] = max(K[i], P[i]);
                BITONIC16
            }
#undef BITONIC16
#undef CEU
            const float inv = mx > mn ? (mx - mn) * (1.f / 8388607.f) : 0.f;
            const float top = (float)(K[0] >> 8);
            float ex[16], sum = 0.f;
#pragma unroll
            for (int k = 0; k < 16; ++k) { ex[k] = __expf(((float)(K[k] >> 8) - top) * inv); sum += ex[k]; }
            const float rs = 1.f / sum;
            const float sh8t = ((const float*)(p.ws + OFF_SH8))[tok];
            const unsigned hsel = 0u - (unsigned)hh;
            int eo[8]; unsigned go[8];
#pragma unroll
            for (int k = 0; k < 8; ++k) {
                const unsigned key = (hsel & K[8 + k]) | (~hsel & K[k]);
                const float gk = __uint_as_float((hsel & __float_as_uint(ex[8 + k])) | (~hsel & __float_as_uint(ex[k]))) * rs;
                const unsigned pos = 255u - (key & 255u);
                const int ei = LI[(0 * 32 + tl) * 16 + (pos >> 4)] * 128 + LI[(1 * 32 + tl) * 16 + (pos & 15u)];
                const f32x2 suv = SUVl[ei];
                eo[k] = ei; go[k] = pack2(gk * suv[1], suv[0] * sh8t);
            }
            int* po = PIDX + (size_t)tok * 128 + h * 16 + 8 * hh;
            *(int4*)po = make_int4(eo[0], eo[1], eo[2], eo[3]); *(int4*)(po + 4) = make_int4(eo[4], eo[5], eo[6], eo[7]);
            uint4* pg = (uint4*)(PGS + (size_t)tok * 128 + h * 16 + 8 * hh);
#pragma unroll
            for (int k = 0; k < 4; ++k) pg[k] = make_uint4((unsigned)eo[2 * k], go[2 * k], (unsigned)eo[2 * k + 1], go[2 * k + 1]);
        }
        __builtin_amdgcn_wave_barrier();
    }
}

#ifndef PEER_TCH_DEF
#define PEER_TCH_DEF 16
#endif
constexpr int PEER_TCH = PEER_TCH_DEF;
constexpr int PEER_NCH = NTOK / PEER_TCH;

DEVI void unpack_fp8x16(const uint4& w, float (&f)[16]) {
    const unsigned wv[4] = {w.x, w.y, w.z, w.w};
#pragma unroll
    for (int q = 0; q < 4; ++q) {
        f32x2 lo = __builtin_amdgcn_cvt_pk_f32_fp8((int)wv[q], false), hi = __builtin_amdgcn_cvt_pk_f32_fp8((int)wv[q], true);
        f[4 * q] = lo[0]; f[4 * q + 1] = lo[1]; f[4 * q + 2] = hi[0]; f[4 * q + 3] = hi[1];
    }
}

DEVI float dot_fp8x16(const uint4& w, const float (&h)[16]) {
    const unsigned wv[4] = {w.x, w.y, w.z, w.w};
    f32x2 s = (f32x2){0.f, 0.f};
#pragma unroll
    for (int q = 0; q < 4; ++q) {
        f32x2 lo = __builtin_amdgcn_cvt_pk_f32_fp8((int)wv[q], false), hi = __builtin_amdgcn_cvt_pk_f32_fp8((int)wv[q], true);
        s += lo * (f32x2){h[4 * q], h[4 * q + 1]};
        s += hi * (f32x2){h[4 * q + 2], h[4 * q + 3]};
    }
    return s[0] + s[1];
}
DEVI void fma_fp8x16(const uint4& w, float a, f32x2 (&acc)[8]) {
    const unsigned wv[4] = {w.x, w.y, w.z, w.w};
    const f32x2 a2 = (f32x2){a, a};
#pragma unroll
    for (int q = 0; q < 4; ++q) {
        f32x2 lo = __builtin_amdgcn_cvt_pk_f32_fp8((int)wv[q], false), hi = __builtin_amdgcn_cvt_pk_f32_fp8((int)wv[q], true);
        acc[2 * q] += a2 * lo; acc[2 * q + 1] += a2 * hi;
    }
}
template <int B0, int B1, int B2>
DEVI void reduce_scatter16(const float (&v)[16], int lane, float (&out)[2]) {
    float r8[8], r4[4];
    { const bool hi = (lane & B0) != 0;
#pragma unroll
      for (int j = 0; j < 8; ++j) { float send = hi ? v[j] : v[8 + j]; float keep = hi ? v[8 + j] : v[j]; r8[j] = keep + __shfl_xor(send, B0); } }
    { const bool hi = (lane & B1) != 0;
#pragma unroll
      for (int j = 0; j < 4; ++j) { float send = hi ? r8[j] : r8[4 + j]; float keep = hi ? r8[4 + j] : r8[j]; r4[j] = keep + __shfl_xor(send, B1); } }
    { const bool hi = (lane & B2) != 0;
#pragma unroll
      for (int j = 0; j < 2; ++j) { float send = hi ? r4[j] : r4[2 + j]; float keep = hi ? r4[2 + j] : r4[j]; out[j] = keep + __shfl_xor(send, B2); } }
}

template <int B0, int B1, int B2, typename T>
DEVI void reduce_scatter16_hi8(const T (&v)[16], int lane, T (&out)[2]) {
    T r8[8], r4[4];
    { const bool hi = (lane & B0) != 0;
#pragma unroll
      for (int j = 0; j < 8; ++j) { const int i = ((j >> 2) << 3) | (j & 3); T send = hi ? v[i] : v[i | 4]; T keep = hi ? v[i | 4] : v[i]; r8[j] = keep + __shfl_xor(send, B0); } }
    { const bool hi = (lane & B1) != 0;
#pragma unroll
      for (int j = 0; j < 4; ++j) { const int i = ((j >> 1) << 2) | (j & 1); T send = hi ? r8[i] : r8[i | 2]; T keep = hi ? r8[i | 2] : r8[i]; r4[j] = keep + __shfl_xor(send, B1); } }
    { const bool hi = (lane & B2) != 0;
#pragma unroll
      for (int j = 0; j < 2; ++j) { const int i = j << 1; T send = hi ? r4[i] : r4[i | 1]; T keep = hi ? r4[i | 1] : r4[i]; out[j] = keep + __shfl_xor(send, B2); } }
}

template <int CTRL> DEVI int dpp_i(int v) { return __builtin_amdgcn_update_dpp(0, v, CTRL, 0xF, 0xF, false); }
DEVI void reduce_scatter16_hi8_dpp(const int (&v)[16], int lane, int (&out)[2]) {
    int r8[8], r4[4];
    { const bool hi = (lane & 4) != 0;
#pragma unroll
      for (int j = 0; j < 8; ++j) { const int i = ((j >> 2) << 3) | (j & 3); int send = hi ? v[i] : v[i | 4]; int keep = hi ? v[i | 4] : v[i]; r8[j] = keep + dpp_i<0x141>(send); } }
    { const bool hi = (lane & 2) != 0;
#pragma unroll
      for (int j = 0; j < 4; ++j) { const int i = ((j >> 1) << 2) | (j & 1); int send = hi ? r8[i] : r8[i | 2]; int keep = hi ? r8[i | 2] : r8[i]; r4[j] = keep + dpp_i<0x4E>(send); } }
    { const bool hi = (lane & 1) != 0;
#pragma unroll
      for (int j = 0; j < 2; ++j) { const int i = j << 1; int send = hi ? r4[i] : r4[i | 1]; int keep = hi ? r4[i | 1] : r4[i]; out[j] = keep + dpp_i<0xB1>(send); } }
}
template <typename T>
DEVI void reduce_scatter16_swap(const T (&v)[16], int lane, T (&out)[2]) {
    T r8[8], r4[4];
#pragma unroll
    for (int j = 0; j < 8; ++j) {
        auto sw = __builtin_amdgcn_permlane32_swap(__builtin_bit_cast(unsigned, v[j]), __builtin_bit_cast(unsigned, v[8 + j]), false, false);
        r8[j] = __builtin_bit_cast(T, (unsigned)sw[0]) + __builtin_bit_cast(T, (unsigned)sw[1]);
    }
#pragma unroll
    for (int j = 0; j < 4; ++j) {
        auto sw = __builtin_amdgcn_permlane16_swap(__builtin_bit_cast(unsigned, r8[j]), __builtin_bit_cast(unsigned, r8[4 + j]), false, false);
        r4[j] = __builtin_bit_cast(T, (unsigned)sw[0]) + __builtin_bit_cast(T, (unsigned)sw[1]);
    }
    { const bool hi = (lane & 8) != 0;
#pragma unroll
      for (int j = 0; j < 2; ++j) { T send = hi ? r4[j] : r4[2 + j]; T keep = hi ? r4[2 + j] : r4[j];
          out[j] = keep + __builtin_bit_cast(T, __builtin_amdgcn_update_dpp(0, __builtin_bit_cast(int, send), 0x128, 0xF, 0xF, false)); } }
}

struct PeerHdrU { int idx0, idx1; uint4 h8; };
struct PeerHdrV { int idx0, idx1; f32x2 gs0, gs1; float act0, act1; };

DEVI void peer_u_load_hdr(const Params& p, int g, int pp, int lane, PeerHdrU& h) {
    const int* PIDX = (const int*)(p.ws + OFF_PIDX);
    h.idx0 = PIDX[(size_t)g * 128 + lane]; h.idx1 = PIDX[(size_t)g * 128 + 64 + lane];
    h.h8 = *(const uint4*)(p.ws + OFF_H8 + (size_t)g * 1024 + 128 * pp + 16 * (lane & 7));
}
DEVI void peer_u_body(const Params& p, int l, int g, int pp, int lane, const PeerHdrU& h) {
    const unsigned char* PU = p.ws + OFF_PU + ((size_t)l * 8 + pp) * 16384 * 128;
    const unsigned lo16 = 16u * (lane & 7);
    const int r = lane >> 3;
    uint4 w[16];
#pragma unroll
    for (int i = 0; i < 16; ++i) {
        int e = __shfl(i < 8 ? h.idx0 : h.idx1, (8 * i + r) & 63);
        w[i] = *(const uint4*)(PU + (((unsigned)e << 7) + lo16));
    }
    int s[16];
#pragma unroll
    for (int i = 0; i < 16; ++i) {
        int d = __builtin_amdgcn_sdot4((int)w[i].x, (int)h.h8.x, 0, false);
        d = __builtin_amdgcn_sdot4((int)w[i].y, (int)h.h8.y, d, false);
        d = __builtin_amdgcn_sdot4((int)w[i].z, (int)h.h8.z, d, false);
        s[i] = __builtin_amdgcn_sdot4((int)w[i].w, (int)h.h8.w, d, false);
    }
    int o[2];
    reduce_scatter16_hi8_dpp(s, lane, o);
    const int ia = lane & 7;
    int* ACT = (int*)(p.ws + OFF_ACT) + (size_t)g * 128;
    (void)__hip_atomic_fetch_add(ACT + 8 * ia + r, o[0], __ATOMIC_RELAXED, __HIP_MEMORY_SCOPE_AGENT);
    (void)__hip_atomic_fetch_add(ACT + 64 + 8 * ia + r, o[1], __ATOMIC_RELAXED, __HIP_MEMORY_SCOPE_AGENT);
}
DEVI void peer_v_load_hdr(const Params& p, int g, int lane, PeerHdrV& h) {
    const uint2* REC = (const uint2*)(p.ws + OFF_PGS);
    const int* ACT = (const int*)(p.ws + OFF_ACT) + (size_t)g * 128;
    const uint2 r0 = REC[(size_t)g * 128 + lane], r1 = REC[(size_t)g * 128 + 64 + lane];
    h.idx0 = (int)r0.x; h.idx1 = (int)r1.x;
    h.gs0 = (f32x2){bflo(r0.y), bfhi(r0.y)}; h.gs1 = (f32x2){bflo(r1.y), bfhi(r1.y)};
    h.act0 = (float)ACT[lane]; h.act1 = (float)ACT[64 + lane];
}
template <int CTRL, int ROWMASK>
DEVI float dpp_f(float v) {
    return __builtin_bit_cast(float, __builtin_amdgcn_update_dpp(__builtin_bit_cast(int, v), __builtin_bit_cast(int, v), CTRL, ROWMASK, 0xF, false));
}
DEVI float gelu_tanh_fast(float x) {
    float y = 0.7978845608028654f * (x + 0.044715f * x * x * x);
    float e = __expf(2.f * y);
    float t = 1.f - 2.f * __builtin_amdgcn_rcpf(e + 1.f);
    return 0.5f * x * (1.f + t);
}
struct PeerG2 { f32x4 g0, g1; int mr; };
DEVI void peer_v_body(const Params& p, int l, int g, int pp, int lane, const PeerHdrV& h, PeerG2& gc) {
    const unsigned char* PV = p.ws + OFF_PV + ((size_t)l * 8 + pp) * 16384 * 128;
    const unsigned lo16 = 16u * (lane & 7);
    const int r = lane >> 3;
    const float a0 = gelu_tanh_fast(h.act0 * h.gs0[1]) * h.gs0[0];
    const float a1 = gelu_tanh_fast(h.act1 * h.gs1[1]) * h.gs1[0];
    uint4 w[16];
#pragma unroll
    for (int i = 0; i < 16; ++i) {
        int e = __shfl(i < 8 ? h.idx0 : h.idx1, (8 * i + r) & 63);
        w[i] = *(const uint4*)(PV + (((unsigned)e << 7) + lo16));
    }
    float am = fmaxf(fabsf(a0), fabsf(a1));
    am = fmaxf(am, dpp_f<0xB1, 0xF>(am));
    am = fmaxf(am, dpp_f<0x4E, 0xF>(am));
    am = fmaxf(am, dpp_f<0x141, 0xF>(am));
    am = fmaxf(am, dpp_f<0x140, 0xF>(am));
    am = fmaxf(am, dpp_f<0x142, 0xA>(am));
    am = fmaxf(am, dpp_f<0x143, 0xC>(am));
    am = __builtin_bit_cast(float, __builtin_amdgcn_readlane(__builtin_bit_cast(int, am), 63));
    const float sa = am > 0.f ? am * (1.f / 127.f) : 1.f, inva = __builtin_amdgcn_rcpf(sa);
    const int col = 128 * pp + 16 * (lane & 7) + (lane & 8);
    float* xp = (float*)(p.ws + OFF_XW) + (size_t)g * 1024 + col;
    f32x4 x0 = (f32x4){0.f, 0.f, 0.f, 0.f}, x1 = x0;
    if (lane < 16) { x0 = *(const f32x4*)xp; x1 = *(const f32x4*)(xp + 4); }
    {
        const int mr = tok_modrow(g);
        if (mr != gc.mr) {
            const float* g2 = (const float*)(p.ws + OFF_MOD) + (size_t)(l * 5 + mr) * 6144 + 5120 + col;
            gc.g0 = *(const f32x4*)g2; gc.g1 = *(const f32x4*)(g2 + 4); gc.mr = mr;
        }
    }
    const f32x4 g0 = gc.g0, g1 = gc.g1;
    typedef int i32x4 __attribute__((ext_vector_type(4)));
    i32x4 A;
    {
        unsigned p0 = (unsigned)(int)__builtin_rintf(a0 * inva) & 0xffu, p1 = (unsigned)(int)__builtin_rintf(a1 * inva) & 0xffu;
        p0 |= (unsigned)__builtin_amdgcn_update_dpp(0, (int)p0, 0x128, 0xF, 0xF, false) << 8;
        p1 |= (unsigned)__builtin_amdgcn_update_dpp(0, (int)p1, 0x128, 0xF, 0xF, false) << 8;
        p0 |= (unsigned)__shfl((int)p0, (lane + 16) & 63) << 16; p1 |= (unsigned)__shfl((int)p1, (lane + 16) & 63) << 16;
        const int rs = ((lane >> 4) << 1) | (lane & 1);
        A = (i32x4){__shfl((int)p0, rs), __shfl((int)p0, 32 + rs), __shfl((int)p1, rs), __shfl((int)p1, 32 + rs)};
    }
    int v[16];
#pragma unroll
    for (int c = 0; c < 4; ++c) {
        unsigned cd[4][4];
#pragma unroll
        for (int q = 0; q < 4; ++q) {
            const unsigned wa = c == 0 ? w[4 * q].x : c == 1 ? w[4 * q].y : c == 2 ? w[4 * q].z : w[4 * q].w;
            const unsigned wb = c == 0 ? w[4 * q + 1].x : c == 1 ? w[4 * q + 1].y : c == 2 ? w[4 * q + 1].z : w[4 * q + 1].w;
            const unsigned wc = c == 0 ? w[4 * q + 2].x : c == 1 ? w[4 * q + 2].y : c == 2 ? w[4 * q + 2].z : w[4 * q + 2].w;
            const unsigned wd = c == 0 ? w[4 * q + 3].x : c == 1 ? w[4 * q + 3].y : c == 2 ? w[4 * q + 3].z : w[4 * q + 3].w;
            const unsigned t0 = __builtin_amdgcn_perm(wb, wa, 0x05010400u), t1 = __builtin_amdgcn_perm(wd, wc, 0x05010400u);
            const unsigned t2 = __builtin_amdgcn_perm(wb, wa, 0x07030602u), t3 = __builtin_amdgcn_perm(wd, wc, 0x07030602u);
            cd[q][0] = __builtin_amdgcn_perm(t1, t0, 0x05040100u); cd[q][1] = __builtin_amdgcn_perm(t1, t0, 0x07060302u);
            cd[q][2] = __builtin_amdgcn_perm(t3, t2, 0x05040100u); cd[q][3] = __builtin_amdgcn_perm(t3, t2, 0x07060302u);
        }
#pragma unroll
        for (int b = 0; b < 4; ++b) {
            const i32x4 B = (i32x4){(int)cd[0][b], (int)cd[1][b], (int)cd[2][b], (int)cd[3][b]};
            const i32x4 C = __builtin_amdgcn_mfma_i32_16x16x64_i8(A, B, (i32x4){0, 0, 0, 0}, 0, 0, 0);
            const int t = (lane & 8) ? C[1] : C[0];
            v[4 * c + b] = t + dpp_i<0x128>(t);
        }
    }
    const int hsel = -((lane >> 3) & 1);
    float o[8];
#pragma unroll
    for (int k = 0; k < 8; ++k) o[k] = sa * (float)((hsel & v[8 + k]) | (~hsel & v[k]));
#pragma unroll
    for (int k = 0; k < 4; ++k) { x0[k] += g0[k] * o[k]; x1[k] += g1[k] * o[4 + k]; }
    if (lane < 16) { *(f32x4*)xp = x0; *(f32x4*)(xp + 4) = x1; }
}

template <int PASS>
DEVI void phase_peer_part(const Params& p, int l) {
    const int tid_ = opaque_tid(); const int lane = tid_ & 63;
    unsigned* cntbase = (unsigned*)(p.ws + OFF_CTL + 16384) + (size_t)((l * 2 + PASS) * 8) * 16;
    const int home = (int)(xb_xcc_id() & 7u);
#pragma unroll 1
    for (int step = 0; step < 8; ++step) {
        const int pp = (home + step) & 7;
        unsigned* cnt = cntbase + pp * 16;
        if (step > 0) { if (xb_ld(cnt) >= (unsigned)PEER_NCH) continue; }
        unsigned cv = 0u;
        if (lane == 0) cv = xb_add(cnt, 1u);
        unsigned c = (unsigned)__builtin_amdgcn_readfirstlane((int)cv);
        while (c < (unsigned)PEER_NCH) {
            unsigned nv = 0u;
            if (lane == 0) nv = xb_add(cnt, 1u);
#ifndef PEER_ROT
#define PEER_ROT 0
#endif
            const int crot = PEER_ROT ? (int)((c + (unsigned)pp * (PEER_NCH / 8) * PEER_ROT) % (unsigned)PEER_NCH) : (int)c;
            const int g0 = crot * PEER_TCH;
            if (PASS == 0) {
                PeerHdrU cur; peer_u_load_hdr(p, g0, pp, lane, cur);
#pragma unroll 1
                for (int t = 0; t < PEER_TCH; ++t) {
                    PeerHdrU nxt; peer_u_load_hdr(p, g0 + (t + 1 < PEER_TCH ? t + 1 : t), pp, lane, nxt);
                    peer_u_body(p, l, g0 + t, pp, lane, cur);
                    cur = nxt;
                }
            } else {
                PeerHdrV cur; peer_v_load_hdr(p, g0, lane, cur);
                PeerG2 gc; gc.mr = -1; gc.g0 = (f32x4){0.f, 0.f, 0.f, 0.f}; gc.g1 = gc.g0;
#pragma unroll 1
                for (int t = 0; t < PEER_TCH; ++t) {
                    PeerHdrV nxt; peer_v_load_hdr(p, g0 + (t + 1 < PEER_TCH ? t + 1 : t), lane, nxt);
                    peer_v_body(p, l, g0 + t, pp, lane, cur, gc);
                    cur = nxt;
                }
            }
            c = (unsigned)__builtin_amdgcn_readfirstlane((int)nv);
        }
    }
}

DEVI void phase_norm_next(const Params& p, int l) {
    const int tid_ = opaque_tid(); const int lane = tid_ & 63, wave = tid_ >> 6;
    const float* mod = (const float*)(p.ws + OFF_MOD);
    const float* xw = (const float*)(p.ws + OFF_XW); bf16* H = (bf16*)(p.ws + OFF_H);
    int g0, g1; wave_rows(wave, g0, g1);
    ModVec mv; int cur = -1;
    for (int g = g0; g < g1; ++g) {
        f32x4 x[4];
#pragma unroll
        for (int j = 0; j < 4; ++j) x[j] = *(const f32x4*)(xw + (size_t)g * 1024 + 4 * lane + 256 * j);
        if (l < NLAYER - 1) {
            const int mr = tok_modrow(g);
            if (mr != cur) { const float* m = mod + (size_t)((l + 1) * 5 + mr) * 6144; load_modvec(mv, p.in[10] + (l + 1) * 1024, m + 1024, m, lane); cur = mr; }
            norm_store_row(x, mv, H + (size_t)g * 1024, lane);
        } else {
            float ss = 0.f;
#pragma unroll
            for (int j = 0; j < 4; ++j) ss += x[j][0] * x[j][0] + x[j][1] * x[j][1] + x[j][2] * x[j][2] + x[j][3] * x[j][3];
            ss = wave_sum(ss);
            float rstd = rsqrtf(ss * (1.f / 1024.f) + EPS);
#pragma unroll
            for (int j = 0; j < 4; ++j) {
                int c0 = 4 * lane + 256 * j;
                f32x4 w = *(const f32x4*)(p.in[27] + c0); f32x4 o;
                o[0] = x[j][0] * rstd * w[0]; o[1] = x[j][1] * rstd * w[1]; o[2] = x[j][2] * rstd * w[2]; o[3] = x[j][3] * rstd * w[3];
                *(f32x4*)(p.out + O_Y + (size_t)g * 1024 + c0) = o;
            }
        }
    }
}

#ifndef PH_MASK
#define PH_MASK 0xFFF
#endif
#define PH_ON(x) (((PH_MASK) >> (x)) & 1)
constexpr int PPL = 11;
constexpr int N_PHASES = 2 + PPL * NLAYER;
__global__ void __launch_bounds__(256, 2) fwd_megakernel(Params p) {
    __shared__ __attribute__((aligned(16))) unsigned char smem[LDS_BYTES];
    XcdBarrier bar; bar.bar = (unsigned*)(p.ws + OFF_CTL); bar.x = 0; bar.nloc = 0u; bar.nx = 0u;
    const bool multi = (p.ph_hi - p.ph_lo) > 1;
    if (multi) bar = xcd_barrier_post((unsigned*)(p.ws + OFF_CTL));
    for (int ph = p.ph_lo; ph < p.ph_hi; ++ph) {
        if (ph == 0) { if (PH_ON(0)) { phase_mod(p, smem); __syncthreads(); phase_convert(p, smem); }
#if defined(REP_PHASE) && REP_PHASE == 100
            __syncthreads(); phase_mod(p, smem);
#endif
        }
        else if (ph == 1) { if (PH_ON(1)) phase_h1_layer0(p);
#if defined(REP_PHASE) && REP_PHASE == 101
            __syncthreads(); phase_convert(p, smem);
#endif
        }
        else {
            const int l = (ph - 2) / PPL, s = (ph - 2) % PPL;
#ifdef REP_PHASE
            if (s == REP_PHASE) {
                switch (s) {
                    case 0: phase_zgemm(p, l, smem); break;
                    case 1: phase_gla_prep(p, l, smem); break;
                    case 2: if (REP_SUB & 1) phase_scan(p, l); if (REP_SUB & 2) phase_attn(p, l, smem, 1); break;
                    case 3: phase_gla_out(p, l); break;
                    case 5: phase_norm2(p, l); break;
                    case 6: phase_qgemm(p, l, smem); break;
                    case 7: phase_peer_score(p, l, smem); break;
                    default: break;
                }
                __syncthreads();
            }
#endif
            switch (s) {
                case 0: if (PH_ON(2)) phase_zgemm(p, l, smem); break;
                case 1: if (PH_ON(3)) phase_gla_prep(p, l, smem); break;
                case 2: if (PH_ON(4)) phase_scan(p, l); if (PH_ON(5)) phase_attn(p, l, smem); break;
                case 3: if (PH_ON(6)) phase_gla_out(p, l); break;
                case 4: if (PH_ON(7)) phase_outgemm(p, l, smem); break;
                case 5: if (PH_ON(8)) phase_norm2(p, l); break;
                case 6: if (PH_ON(9)) phase_qgemm(p, l, smem); break;
                case 7: if (PH_ON(10)) phase_peer_score(p, l, smem); break;
                case 8: if (PH_ON(11)) phase_peer_part<0>(p, l); break;
                case 9: if (PH_ON(11)) phase_peer_part<1>(p, l); break;
                default: if (PH_ON(11)) phase_norm_next(p, l); break;
            }
        }
        if (ph + 1 < p.ph_hi) { xcd_barrier(bar);
#if defined(REP_PHASE) && REP_PHASE == 200
            xcd_barrier(bar);
#endif
        }
    }
}

extern "C" void kernel_launch(void* const* d_in, const int* in_sizes, int n_in, void* d_out, int out_size, void* d_ws, size_t ws_size, hipStream_t stream) {
    static int grid = 0;
    if (grid == 0) {
        int dev = 0, cus = 0, per_cu = 0;
        if (n_in != 28 || ws_size < WS_END) { fprintf(stderr, "kernel_launch: unexpected inputs (n_in %d, ws %zu, need %zu)\n", n_in, ws_size, (size_t)WS_END); grid = -1; return; }
        hipGetDevice(&dev);
        hipDeviceGetAttribute(&cus, hipDeviceAttributeMultiprocessorCount, dev);
        if (hipOccupancyMaxActiveBlocksPerMultiprocessor(&per_cu, (const void*)fwd_megakernel, 256, 0) != hipSuccess) per_cu = 0;
        (void)hipGetLastError();
        if (per_cu > 2) per_cu = 2;
        if (per_cu < 1) { fprintf(stderr, "kernel_launch: occupancy query returned %d\n", per_cu); grid = -1; return; }
        grid = cus * per_cu;
    }
    if (grid < 0) return;
    Params p{};
    for (int i = 0; i < 28; ++i) p.in[i] = (const float*)d_in[i];
    p.out = (float*)d_out; p.ws = (unsigned char*)d_ws;
#if MULTI_LAUNCH
    for (int ph = 0; ph < N_PHASES; ++ph) {
        p.ph_lo = ph; p.ph_hi = ph + 1;
        hipLaunchKernelGGL(fwd_megakernel, dim3(grid), dim3(256), 0, stream, p);
    }
#else
    hipMemsetAsync((char*)d_ws + OFF_CTL, 0, 32768, stream);
    p.ph_lo = 0; p.ph_hi = N_PHASES;
    hipLaunchKernelGGL(fwd_megakernel, dim3(grid), dim3(256), 0, stream, p);
#endif
}
```
